# Optimizing an MI355X kernel written in HIP

```python
import jax, jax.numpy as jnp
from jax import lax
import numpy as np

D_MODEL = 1024
BATCH = 16
SEQ = 2048
DEPTH = 1

HEAD_DIM = 64
N_HEADS_SB = 8
N_HEADS_DSA = 8
N_IDX_HEADS = 8
IDX_DIM = 64
TOPK_MAX = 256
D_FF = 2816
PLE_DIM = 256
ROPE_THETA = 500000.0
ROPE_DIM = HEAD_DIM // 4
Q_BLOCK = 128
EPS = 1e-6

W_SB = N_HEADS_SB * HEAD_DIM
W_DSA = N_HEADS_DSA * HEAD_DIM
SPLIT_SIZES = (W_SB, W_SB, W_SB,
               W_DSA, HEAD_DIM, HEAD_DIM,
               N_IDX_HEADS * IDX_DIM, IDX_DIM, N_IDX_HEADS,
               D_MODEL, D_MODEL)
D_IN = 3 * W_SB + W_DSA + 2 * HEAD_DIM + N_IDX_HEADS * IDX_DIM + IDX_DIM + N_IDX_HEADS + 2 * D_MODEL

kernel_name = "hybrid_stickbreak_dsa_macaron_block"


def rmsnorm(x, g):
    xf = x.astype(jnp.float32)
    y = xf * lax.rsqrt(jnp.mean(xf * xf, axis=-1, keepdims=True) + EPS)
    return (y * g.astype(jnp.float32)).astype(x.dtype)


def partial_rotary(x, positions):
    half = ROPE_DIM // 2
    inv_freq = ROPE_THETA ** (-jnp.arange(0, ROPE_DIM, 2, dtype=jnp.float32) / ROPE_DIM)
    ang = positions.astype(jnp.float32)[..., None] * inv_freq
    extra = x.ndim - 3
    ang = ang.reshape(ang.shape[:2] + (1,) * extra + (half,))
    cos, sin = jnp.cos(ang), jnp.sin(ang)
    xf = x.astype(jnp.float32)
    x1, x2, rest = xf[..., :half], xf[..., half:ROPE_DIM], xf[..., ROPE_DIM:]
    out = jnp.concatenate([x1 * cos - x2 * sin, x2 * cos + x1 * sin, rest], axis=-1)
    return out.astype(x.dtype)


def swiglu(x, w1, w2):
    a, b = jnp.split(x @ w1, 2, axis=-1)
    return (jax.nn.silu(a) * b) @ w2


def to_blocks(a):
    B, S = a.shape[:2]
    return jnp.moveaxis(a.reshape((B, S // Q_BLOCK, Q_BLOCK) + a.shape[2:]), 1, 0)


def from_blocks(a):
    a = jnp.moveaxis(a, 0, 1)
    return a.reshape((a.shape[0], a.shape[1] * a.shape[2]) + a.shape[3:])


def stick_breaking_attention(q, k, v):
    S, d = q.shape[1], q.shape[3]
    nb = S // Q_BLOCK
    key_idx = jnp.arange(S)

    def block(args):
        blk, qb = args
        t = blk * Q_BLOCK + jnp.arange(Q_BLOCK)
        causal = (key_idx[None, :] < t[:, None])[None, None]
        z = jnp.einsum('bqhd,bkhd->bhqk', qb, k).astype(jnp.float32) * (d ** -0.5)
        log_keep = jnp.where(causal, jax.nn.log_sigmoid(-z), 0.0)
        log_prefix = lax.cumsum(log_keep, axis=3, reverse=True) - log_keep
        a = jnp.where(causal, jnp.exp(jax.nn.log_sigmoid(z) + log_prefix), 0.0)
        return jnp.einsum('bhqk,bkhd->bqhd', a.astype(v.dtype), v)

    out = lax.map(block, (jnp.arange(nb), to_blocks(q)))
    return from_blocks(out)


def dsa_attention(q, k, v, q_idx, k_idx, w_idx):
    S, d = q.shape[1], q.shape[3]
    nb = S // Q_BLOCK
    n_sel = min(TOPK_MAX, S // 4)
    key_idx = jnp.arange(S)
    gather = jax.vmap(lambda src, ids: src[ids])

    def block(args):
        blk, qb, qib, wib = args
        t = blk * Q_BLOCK + jnp.arange(Q_BLOCK)
        causal = key_idx[None, :] <= t[:, None]
        dots = jnp.einsum('bqhd,bkd->bqhk', qib, k_idx).astype(jnp.float32) * (IDX_DIM ** -0.5)
        score = jnp.einsum('bqh,bqhk->bqk',
                           wib.astype(jnp.float32) * (N_IDX_HEADS ** -0.5), jax.nn.relu(dots))
        score = jnp.where(causal[None], score, -jnp.inf)
        _, sel = lax.top_k(score, n_sel)
        valid = sel <= t[None, :, None]
        k_sel = gather(k, sel)
        v_sel = gather(v, sel)
        logits = jnp.einsum('bqhd,bqnd->bqhn', qb, k_sel).astype(jnp.float32) * (d ** -0.5)
        logits = jnp.where(valid[:, :, None, :], logits, -jnp.inf)
        probs = jax.nn.softmax(logits, axis=-1)
        return jnp.einsum('bqhn,bqnd->bqhd', probs.astype(v.dtype), v_sel)

    out = lax.map(block, (jnp.arange(nb), to_blocks(q), to_blocks(q_idx), to_blocks(w_idx)))
    return from_blocks(out)


def split_columns(c):
    parts, off = [], 0
    for size in SPLIT_SIZES:
        parts.append(c[..., off:off + size])
        off += size
    return parts


def setup_inputs(seed: int = 0) -> dict:
    key = jax.random.key(seed)
    ks = jax.random.split(key, 20)
    f32 = jnp.float32

    def w(k, shape, fan_in):
        return jax.random.normal(k, shape, f32) * (fan_in ** -0.5)

    def gain(k, shape):
        return 1.0 + 0.01 * jax.random.normal(k, shape, f32)

    return {
        "x": jax.random.normal(ks[0], (BATCH, SEQ, D_MODEL), f32),
        "p": jax.random.normal(ks[1], (DEPTH, BATCH, SEQ, PLE_DIM), f32),
        "positions": jnp.broadcast_to(jnp.arange(SEQ, dtype=jnp.int32), (BATCH, SEQ)),
        "ffn1_norm": gain(ks[2], (DEPTH, D_MODEL)),
        "ffn1_w1": w(ks[3], (DEPTH, D_MODEL, 2 * D_FF), D_MODEL),
        "ffn1_w2": w(ks[4], (DEPTH, D_FF, D_MODEL), D_FF),
        "mix_norm": gain(ks[5], (DEPTH, D_MODEL)),
        "w_in": w(ks[6], (DEPTH, D_MODEL, D_IN), D_MODEL),
        "w_out_sb": w(ks[7], (DEPTH, W_SB, D_MODEL), W_SB),
        "w_out_dsa": w(ks[8], (DEPTH, W_DSA, D_MODEL), W_DSA),
        "w_out": w(ks[9], (DEPTH, D_MODEL, D_MODEL), D_MODEL),
        "ffn2_norm": gain(ks[10], (DEPTH, D_MODEL)),
        "ffn2_w1": w(ks[11], (DEPTH, D_MODEL, 2 * D_FF), D_MODEL),
        "ffn2_w2": w(ks[12], (DEPTH, D_FF, D_MODEL), D_FF),
        "ple_norm": gain(ks[13], (DEPTH, D_MODEL)),
        "ple_w_gate": w(ks[14], (DEPTH, D_MODEL, D_MODEL), D_MODEL),
        "ple_w_proj": w(ks[15], (DEPTH, PLE_DIM, D_MODEL), PLE_DIM),
        "final_norm": gain(ks[16], (D_MODEL,)),
    }


def reference(x, p, positions, ffn1_norm, ffn1_w1, ffn1_w2, mix_norm, w_in, w_out_sb,
              w_out_dsa, w_out, ffn2_norm, ffn2_w1, ffn2_w2, ple_norm, ple_w_gate,
              ple_w_proj, final_norm):
    B, S, _ = x.shape
    h = x
    for i in range(DEPTH):
        h = h + 0.5 * swiglu(rmsnorm(h, ffn1_norm[i]), ffn1_w1[i], ffn1_w2[i])

        u = rmsnorm(h, mix_norm[i])
        (q_sb, k_sb, v_sb, q_d, k_d, v_d, q_i, k_i, w_i, g_sb, g_dsa) = split_columns(u @ w_in[i])

        y_sb = stick_breaking_attention(q_sb.reshape(B, S, N_HEADS_SB, HEAD_DIM),
                                        k_sb.reshape(B, S, N_HEADS_SB, HEAD_DIM),
                                        v_sb.reshape(B, S, N_HEADS_SB, HEAD_DIM))
        y_sb = y_sb.reshape(B, S, W_SB) @ w_out_sb[i]

        q_d = partial_rotary(q_d.reshape(B, S, N_HEADS_DSA, HEAD_DIM), positions)
        k_d = partial_rotary(k_d, positions)
        q_i = partial_rotary(q_i.reshape(B, S, N_IDX_HEADS, IDX_DIM), positions)
        k_i = partial_rotary(k_i, positions)
        y_dsa = dsa_attention(q_d, k_d, v_d, q_i, k_i, w_i)
        y_dsa = y_dsa.reshape(B, S, W_DSA) @ w_out_dsa[i]

        merged = jax.nn.sigmoid(g_sb) * y_sb + jax.nn.sigmoid(g_dsa) * y_dsa
        h = h + merged @ w_out[i]

        h = h + 0.5 * swiglu(rmsnorm(h, ffn2_norm[i]), ffn2_w1[i], ffn2_w2[i])

        ple_gate = jax.nn.sigmoid(rmsnorm(h, ple_norm[i]) @ ple_w_gate[i])
        h = h + ple_gate * (p[i] @ ple_w_proj[i])
    return rmsnorm(h, final_norm)
```

```cpp
#include <hip/hip_runtime.h>
#include <hip/hip_cooperative_groups.h>
#include <hip/hip_bf16.h>
#include <cstdio>
#include <cstdint>
#include <cmath>
namespace cg = cooperative_groups;
__device__ __forceinline__ int mk_lane() { int l; asm volatile("v_mbcnt_lo_u32_b32 %0, -1, 0\n\tv_mbcnt_hi_u32_b32 %0, -1, %0" : "=v"(l)); return l; }
#define MK_N_LAUNCHES 1
namespace pg8 {
#define PG8_LAS __attribute__((address_space(3)))
typedef unsigned short bf16_t;
typedef short bf16x8 __attribute__((ext_vector_type(8)));
typedef float f32x4 __attribute__((ext_vector_type(4)));
typedef unsigned u32x4 __attribute__((ext_vector_type(4)));
constexpr int BM = 256, BK = 64, HALF = 128, HTB = HALF * BK * 2  , STAGE_BYTES = 8 * HTB, NXCD = 8, WGM = 8;

__host__ __device__ __forceinline__ int lds_byte(int r, int c) { const int st = (r >> 4) * 2 + (c >> 5), rr = r & 15, cc = c & 31, ob = rr * 64 + cc * 2; return st * 1024 + (ob ^ (((ob >> 9) & 1) << 5)); }
__host__ __device__ __forceinline__ void stage_rc(int b, int& R, int& C) { const int st = b / 1024, sb = b % 1024, swz = sb ^ (((sb >> 9) & 1) << 5); R = (st >> 1) * 16 + swz / 64; C = (st & 1) * 32 + (swz % 64) / 2; }
__host__ __device__ __forceinline__ int perm32(int rho) { const int n = rho >> 4, i = rho & 15; return 8 * (i >> 2) + 4 * n + (i & 3); }

struct Unit { int pm, pn; };
struct Gemm { const bf16_t* A; const bf16_t* Bt; int M, N, K; };

struct StaticOrder {
    int nM, nN, nwg, G, c;
    __host__ __device__ void init(int M, int N, int G_, int c_) { nM = M / BM; nN = N / BM; nwg = nM * nN; G = G_; c = c_; }
    __host__ __device__ bool next(int i, Unit& u) const {
        const long L = (long)i * G + c; if (L >= nwg) return false;
        int wgid = (int)L; { const int q = nwg / NXCD, r = nwg % NXCD, xcd = wgid % NXCD, off = wgid / NXCD; wgid = (xcd < r ? xcd * (q + 1) : r * (q + 1) + (xcd - r) * q) + off; }
        const int nig = WGM * nN, gid = wgid / nig, fm = gid * WGM, gsz = (nM - fm) < WGM ? (nM - fm) : WGM;
        u.pm = fm + ((wgid % nig) % gsz); u.pn = (wgid % nig) / gsz; return true;
    }
    __device__ __forceinline__ void a_ready(const Unit&) const {}
    __device__ __forceinline__ void done(const Unit&) const {}
};

typedef float f32x2_cv __attribute__((ext_vector_type(2))); typedef __bf16 bf16x2_cv __attribute__((ext_vector_type(2)));
__device__ __forceinline__ unsigned cvt_pk_bf16(float lo, float hi) { f32x2_cv v = {lo, hi}; bf16x2_cv b = __builtin_convertvector(v, bf16x2_cv); return __builtin_bit_cast(unsigned, b); }
typedef float f32x2 __attribute__((ext_vector_type(2)));
typedef unsigned u32x2 __attribute__((ext_vector_type(2)));
__device__ __forceinline__ float bf2f(unsigned short b) { return __uint_as_float(((unsigned)b) << 16); }
__device__ __forceinline__ float row_rstd(const float* ss, int row) {
    const f32x4* p = (const f32x4*)(ss + (size_t)row * 16);
    const f32x4 a = p[0], b = p[1], c = p[2], d = p[3];
    const float s = (((a[0] + a[1]) + (a[2] + a[3])) + ((b[0] + b[1]) + (b[2] + b[3]))) + (((c[0] + c[1]) + (c[2] + c[3])) + ((d[0] + d[1]) + (d[2] + d[3])));
    return __builtin_amdgcn_rsqf(s * (1.0f / 1024.0f) + 1e-6f);
}
struct RstdTab { const PG8_LAS float* tab; int pmA; };
template <class Sched> __device__ __forceinline__ RstdTab build_rstd_tab(PG8_LAS float* tab, const float* ss, const Sched& S, int wid) {
    Unit u; int pmA = -1, pmB = -1;
    for (int i = 0; S.next(i, u); ++i) { if (pmA < 0) pmA = u.pm; else if (u.pm != pmA) pmB = u.pm; }
    const int t = wid * 64 + mk_lane(); const int pm = t < 256 ? pmA : pmB;
    if (pm >= 0) tab[t] = row_rstd(ss, pm * BM + (t & 255));
    __syncthreads();
    return RstdTab{tab, pmA};
}
__device__ __forceinline__ float sigmoid_f(float v) { return __builtin_amdgcn_rcpf(1.0f + __builtin_amdgcn_exp2f(-1.4426950408889634f * v)); }
__device__ __forceinline__ float silu_f(float v) { return v * sigmoid_f(v); }

typedef unsigned u32x4 __attribute__((ext_vector_type(4)));
__device__ __forceinline__ f32x4 bf_lo4(u32x4 w) { f32x4 r; r[0] = __uint_as_float(w.x << 16); r[1] = __uint_as_float(w.x & 0xffff0000u); r[2] = __uint_as_float(w.y << 16); r[3] = __uint_as_float(w.y & 0xffff0000u); return r; }
__device__ __forceinline__ f32x4 bf_hi4(u32x4 w) { f32x4 r; r[0] = __uint_as_float(w.z << 16); r[1] = __uint_as_float(w.z & 0xffff0000u); r[2] = __uint_as_float(w.w << 16); r[3] = __uint_as_float(w.w & 0xffff0000u); return r; }
__device__ __forceinline__ u32x4 pack8(f32x4 a, f32x4 b) { u32x4 w; w.x = cvt_pk_bf16(a[0], a[1]); w.y = cvt_pk_bf16(a[2], a[3]); w.z = cvt_pk_bf16(b[0], b[1]); w.w = cvt_pk_bf16(b[2], b[3]); return w; }

#ifndef PROBE_SWIGLU
#define PROBE_SWIGLU false
#endif
#ifndef PROBE_WIN
#define PROBE_WIN false
#endif
struct EpiSwiGLU {
    static constexpr bool PERM = true, AFTER_DRAIN = false, IDEMPOTENT = PROBE_SWIGLU; static constexpr int MID_T = -1;
    bf16_t* O; int ldo; RstdTab rt;
    __device__ __forceinline__ void operator()(const f32x4 (&acc)[2][2][4][2], const Unit& u, int wr, int wc, int fr, int fq) const {
        const int row0 = u.pm * BM + wr * 64 + fr; const int col0 = u.pn * HALF + wc * 32 + 8 * fq;
        const PG8_LAS float* rtab = rt.tab + (u.pm == rt.pmA ? 0 : 256) + wr * 64 + fr;
#pragma unroll
        for (int ai = 0; ai < 2; ++ai)
#pragma unroll
            for (int m = 0; m < 4; ++m) { if (m == 0) asm volatile("" ::: "memory");
                const int row = row0 + ai * HALF + m * 16; const float rs = rtab[ai * HALF + m * 16];
                const f32x4 a0 = acc[ai][0][m][0] * rs, a1 = acc[ai][0][m][1] * rs, b0 = acc[ai][1][m][0] * rs, b1 = acc[ai][1][m][1] * rs;
                f32x4 o0, o1;
#pragma unroll
                for (int e = 0; e < 4; ++e) { o0[e] = silu_f(a0[e]) * b0[e]; o1[e] = silu_f(a1[e]) * b1[e]; }
                *(u32x4*)(O + (size_t)row * ldo + col0) = pack8(o0, o1);
            }
    }
};

template <bool BASE_F32> struct EpiResid {
    static constexpr bool PERM = true, AFTER_DRAIN = false, IDEMPOTENT = false; static constexpr int MID_T = -1;
    const void* base; bf16_t* outb; float* ss_out; float scale; int ldo;
    __device__ __forceinline__ void operator()(const f32x4 (&acc)[2][2][4][2], const Unit& u, int wr, int wc, int fr, int fq) const {
        const int row0 = u.pm * BM + wr * 64 + fr; const int col0 = u.pn * BM + wc * 32 + 8 * fq;
#pragma unroll
        for (int ai = 0; ai < 2; ++ai)
#pragma unroll
            for (int m = 0; m < 4; ++m) { if (m == 0) asm volatile("" ::: "memory");
                const int row = row0 + ai * HALF + m * 16; const size_t off = (size_t)row * 1024 + col0; float q = 0.f;
#pragma unroll
                for (int bj = 0; bj < 2; ++bj) {
                    f32x4 b0, b1;
                    if (BASE_F32) { b0 = *(const f32x4*)((const float*)base + off + bj * HALF); b1 = *(const f32x4*)((const float*)base + off + bj * HALF + 4); }
                    else { const u32x4 bw = *(const u32x4*)((const bf16_t*)base + off + bj * HALF); b0 = bf_lo4(bw); b1 = bf_hi4(bw); }
                    const f32x4 o0 = b0 + acc[ai][bj][m][0] * scale, o1 = b1 + acc[ai][bj][m][1] * scale;
                    q += ((o0[0] * o0[0] + o0[1] * o0[1]) + (o0[2] * o0[2] + o0[3] * o0[3])) + ((o1[0] * o1[0] + o1[1] * o1[1]) + (o1[2] * o1[2] + o1[3] * o1[3]));
                    *(u32x4*)(outb + (size_t)row * ldo + col0 + bj * HALF) = pack8(o0, o1);
                }
                q += __shfl_xor(q, 16); q += __shfl_xor(q, 32);
                if (fq == 0) ss_out[(size_t)row * 16 + u.pn * 4 + wc] = q;
            }
    }
};

struct EpiWin {
    static constexpr bool PERM = true, AFTER_DRAIN = false, IDEMPOTENT = PROBE_WIN; static constexpr int MID_T = -1;
    bf16_t* qkv; bf16_t* gates; float* wi; RstdTab rt; const float* rot; float c2, wscale;
    __device__ __forceinline__ void operator()(const f32x4 (&acc)[2][2][4][2], const Unit& u, int wr, int wc, int fr, int fq) const {
        const int row0 = u.pm * BM + wr * 64 + fr; const int pn = u.pn;
        const bool rot_tile = (pn >= 6 && pn <= 10);
        const float qs = (pn <= 1 || pn == 6 || pn == 7) ? c2 : 1.0f;
        const PG8_LAS float* rtab = rt.tab + (u.pm == rt.pmA ? 0 : 256) + wr * 64 + fr;
#pragma unroll
        for (int ai = 0; ai < 2; ++ai)
#pragma unroll
            for (int m = 0; m < 4; ++m) { if (m == 0) asm volatile("" ::: "memory");
                const int row = row0 + ai * HALF + m * 16; const float rs = rtab[ai * HALF + m * 16];
#pragma unroll
                for (int bj = 0; bj < 2; ++bj) {
                    f32x4 v0 = acc[ai][bj][m][0] * rs, v1 = acc[ai][bj][m][1] * rs;
                    const int vcol = 128 * bj + 32 * wc + 8 * fq;
                    if (pn <= 10) {
                        const int g = 2 * bj + (wc >> 1);
                        if (rot_tile && (wc & 1) == 0 && (pn != 10 || g == 0 || g == 2)) {
                            if (fq < 2) { const f32x4 c0 = *(const f32x4*)(rot + (size_t)row * 16 + 8 * fq), c1 = *(const f32x4*)(rot + (size_t)row * 16 + 8 * fq + 4);
                                const f32x4 x = v0, y = v1;
                                v0[0] = x[0] * c0[0] - x[1] * c0[1]; v0[1] = x[1] * c0[0] + x[0] * c0[1]; v0[2] = x[2] * c0[2] - x[3] * c0[3]; v0[3] = x[3] * c0[2] + x[2] * c0[3];
                                v1[0] = y[0] * c1[0] - y[1] * c1[1]; v1[1] = y[1] * c1[0] + y[0] * c1[1]; v1[2] = y[2] * c1[2] - y[3] * c1[3]; v1[3] = y[3] * c1[2] + y[2] * c1[3]; }
                        }
                        if (pn == 10 && g == 3) {
                            if (wc == 2 && fq == 0) { *(f32x4*)(wi + (size_t)row * 8) = v0 * wscale; *(f32x4*)(wi + (size_t)row * 8 + 4) = v1 * wscale; }
                        } else *(u32x4*)(qkv + (size_t)row * 2816 + pn * 256 + vcol) = pack8(v0 * qs, v1 * qs);
                    } else {
                        f32x4 s0, s1;
#pragma unroll
                        for (int e = 0; e < 4; ++e) { s0[e] = sigmoid_f(v0[e]); s1[e] = sigmoid_f(v1[e]); }
                        *(u32x4*)(gates + (size_t)row * 2048 + (pn - 11) * 256 + vcol) = pack8(s0, s1);
                    }
                }
            }
    }
};

struct EpiMerge {
    static constexpr bool PERM = true, AFTER_DRAIN = false, IDEMPOTENT = false; static constexpr int MID_T = 8;
    const bf16_t* gate; bf16_t* out;
    __device__ __forceinline__ void mid(f32x4 (&acc)[2][2][4][2], const Unit& u, int wr, int wc, int fr, int fq) const {
        const int row0 = u.pm * BM + wr * 64 + fr; const int col0 = u.pn * BM + wc * 32 + 8 * fq;
#pragma unroll
        for (int ai = 0; ai < 2; ++ai)
#pragma unroll
            for (int m = 0; m < 4; ++m) {
                const bf16_t* gp = gate + (size_t)(row0 + ai * HALF + m * 16) * 2048 + col0;
#pragma unroll
                for (int bj = 0; bj < 2; ++bj) { asm volatile("" ::: "memory");
                    const u32x4 ga = *(const u32x4*)(gp + bj * HALF), gb = *(const u32x4*)(gp + 1024 + bj * HALF);
                    const f32x4 a0 = bf_lo4(ga), a1 = bf_hi4(ga), b0 = bf_lo4(gb), b1 = bf_hi4(gb);
#pragma unroll
                    for (int e = 0; e < 4; ++e) { acc[ai][bj][m][0][e] *= a0[e] * __builtin_amdgcn_rcpf(fmaxf(b0[e], 1e-30f)); acc[ai][bj][m][1][e] *= a1[e] * __builtin_amdgcn_rcpf(fmaxf(b1[e], 1e-30f)); }
                }
            }
    }
    __device__ __forceinline__ void operator()(const f32x4 (&acc)[2][2][4][2], const Unit& u, int wr, int wc, int fr, int fq) const {
        const int row0 = u.pm * BM + wr * 64 + fr; const int col0 = u.pn * BM + wc * 32 + 8 * fq;
#pragma unroll
        for (int ai = 0; ai < 2; ++ai)
#pragma unroll
            for (int m = 0; m < 4; ++m) { if (m == 0) asm volatile("" ::: "memory");
                const int row = row0 + ai * HALF + m * 16;
#pragma unroll
                for (int bj = 0; bj < 2; ++bj) {
                    const u32x4 gb = *(const u32x4*)(gate + (size_t)row * 2048 + 1024 + col0 + bj * HALF);
                    f32x4 b0 = bf_lo4(gb), b1 = bf_hi4(gb);
#pragma unroll
                    for (int e = 0; e < 4; ++e) { b0[e] = fmaxf(b0[e], 1e-30f); b1[e] = fmaxf(b1[e], 1e-30f); }
                    *(u32x4*)(out + (size_t)row * 1024 + col0 + bj * HALF) = pack8(acc[ai][bj][m][0] * b0, acc[ai][bj][m][1] * b1);
                }
            }
    }
};

struct EpiPleM {
    static constexpr bool PERM = true, AFTER_DRAIN = false, IDEMPOTENT = false; static constexpr int MID_T = 4;
    const bf16_t* base; int ldb; bf16_t* outb; bf16_t* tmp; float* ss_out; RstdTab rt;
    __device__ __forceinline__ void mid(f32x4 (&acc)[2][2][4][2], const Unit& u, int wr, int wc, int fr, int fq) const {
        const int row0 = u.pm * BM + wr * 64 + fr; const int col0 = u.pn * BM + wc * 32 + 8 * fq;
#pragma unroll
        for (int ai = 0; ai < 2; ++ai)
#pragma unroll
            for (int m = 0; m < 4; ++m)
#pragma unroll
                for (int bj = 0; bj < 2; ++bj) {
                    *(u32x4*)(tmp + (size_t)(row0 + ai * HALF + m * 16) * 1024 + col0 + bj * HALF) = pack8(acc[ai][bj][m][0], acc[ai][bj][m][1]);
                    acc[ai][bj][m][0] = (f32x4){0.f, 0.f, 0.f, 0.f}; acc[ai][bj][m][1] = (f32x4){0.f, 0.f, 0.f, 0.f};
                }
    }
    __device__ __forceinline__ void operator()(const f32x4 (&acc)[2][2][4][2], const Unit& u, int wr, int wc, int fr, int fq) const {
        const int row0 = u.pm * BM + wr * 64 + fr; const int col0 = u.pn * BM + wc * 32 + 8 * fq;
        const PG8_LAS float* rtab = rt.tab + (u.pm == rt.pmA ? 0 : 256) + wr * 64 + fr;
        __builtin_amdgcn_fence(__ATOMIC_ACQUIRE, "agent");
#pragma unroll
        for (int ai = 0; ai < 2; ++ai)
#pragma unroll
            for (int m = 0; m < 4; ++m) { if (m == 0) asm volatile("" ::: "memory");
                const int row = row0 + ai * HALF + m * 16; const float rs = rtab[ai * HALF + m * 16]; float q = 0.f;
#pragma unroll
                for (int bj = 0; bj < 2; ++bj) {
                    const u32x4 tw = *(const u32x4*)(tmp + (size_t)row * 1024 + col0 + bj * HALF), bw = *(const u32x4*)(base + (size_t)row * ldb + col0 + bj * HALF);
                    const f32x4 a0 = acc[ai][bj][m][0] * rs, a1 = acc[ai][bj][m][1] * rs; f32x4 o0 = bf_lo4(bw), o1 = bf_hi4(bw); const f32x4 t0 = bf_lo4(tw), t1 = bf_hi4(tw);
#pragma unroll
                    for (int e = 0; e < 4; ++e) { o0[e] += sigmoid_f(a0[e]) * t0[e]; o1[e] += sigmoid_f(a1[e]) * t1[e]; }
                    q += ((o0[0] * o0[0] + o0[1] * o0[1]) + (o0[2] * o0[2] + o0[3] * o0[3])) + ((o1[0] * o1[0] + o1[1] * o1[1]) + (o1[2] * o1[2] + o1[3] * o1[3]));
                    *(u32x4*)(outb + (size_t)row * 1024 + col0 + bj * HALF) = pack8(o0, o1);
                }
                q += __shfl_xor(q, 16); q += __shfl_xor(q, 32);
                if (fq == 0) ss_out[(size_t)row * 16 + u.pn * 4 + wc] = q;
            }
    }
};
template <class Epi, class Sched, bool ALIGN_EPI = false, bool SP2 = false>
__device__ __forceinline__ void gemm_phase(PG8_LAS unsigned char* lds, const Gemm g, const Sched& S, const Epi& E, const int wid) {
    const int lane = mk_lane(), tid = wid * 64 + lane, wr = wid >> 2, wc = wid & 3, fr = lane & 15, fq = lane >> 4;
    int K_ = g.K; asm volatile("" : "+s"(K_)); const int K = K_, nt = K / BK;
    unsigned voffA[2], voffB[2];
#pragma unroll
    for (int i = 0; i < 2; ++i) { int R, C; stage_rc(tid * 16 + i * 8192, R, C); const int Rb = Epi::PERM ? ((R & ~31) + perm32(R & 31)) : R;
        voffA[i] = (unsigned)(R * K + C) * 2u; voffB[i] = (unsigned)(Rb * K + C) * 2u; }
    const size_t kstep = (size_t)(BK * 2);
    const size_t hstep = (size_t)HALF * K * 2;
    const size_t tstep = 2 * hstep;
    const unsigned ldsw = (unsigned)wid * 1024u;
    const int aoff = lds_byte(wr * 64 + fr, fq * 8), boff = lds_byte(wc * 32 + fr, fq * 8);
#define PG8_SA(b, h) (((b) * 2 + (h)) * HTB)
#define PG8_SB(b, h) ((4 + (b) * 2 + (h)) * HTB)
#define PG8_STAGE(bufoff, gbase, voff) do { _Pragma("unroll") for (int _i = 0; _i < 2; ++_i) \
        __builtin_amdgcn_global_load_lds((const unsigned*)((const char*)(gbase) + (voff)[_i]), (PG8_LAS unsigned*)(lds + (bufoff) + ldsw + _i * 8192), 16, 0, 0); } while (0)
#define PG8_LDA(dst, b, h) do { _Pragma("unroll") for (int m = 0; m < 4; ++m) _Pragma("unroll") for (int k = 0; k < 2; ++k) dst[m][k] = *(const PG8_LAS bf16x8*)(lds + PG8_SA(b, h) + aoff + m * 2048 + k * 1024); } while (0)
#define PG8_LDB(dst, b, h) do { _Pragma("unroll") for (int n = 0; n < 2; ++n) _Pragma("unroll") for (int k = 0; k < 2; ++k) dst[n][k] = *(const PG8_LAS bf16x8*)(lds + PG8_SB(b, h) + boff + n * 2048 + k * 1024); } while (0)
#define PG8_MMA(ai, bj, At, Bt) do { __builtin_amdgcn_s_setprio(1); _Pragma("unroll") for (int m = 0; m < 4; ++m) _Pragma("unroll") for (int n = 0; n < 2; ++n) _Pragma("unroll") for (int k = 0; k < 2; ++k) \
        acc[ai][bj][m][n] = __builtin_amdgcn_mfma_f32_16x16x32_bf16(Bt[n][k], At[m][k], acc[ai][bj][m][n], 0, 0, 0); __builtin_amdgcn_s_setprio(0); } while (0)
#define PG8_WAIT_V(n) asm volatile("s_waitcnt vmcnt(" #n ")" ::: "memory")
#define PG8_WAIT_L(n) asm volatile("s_waitcnt lgkmcnt(" #n ")" ::: "memory")
#define PG8_BAR __builtin_amdgcn_s_barrier()
#define PG8_SCHED __builtin_amdgcn_sched_barrier(0)
    Unit cur, nxt; int ui = 0;
    if (!S.next(0, cur)) return;
    f32x4 acc[2][2][4][2];
#pragma unroll
    for (int a = 0; a < 2; ++a)
#pragma unroll
        for (int b = 0; b < 2; ++b)
#pragma unroll
            for (int m = 0; m < 4; ++m)
#pragma unroll
                for (int n = 0; n < 2; ++n) acc[a][b][m][n] = (f32x4){0.f, 0.f, 0.f, 0.f};
    bf16x8 At[4][2], B0[2][2], B1[2][2];
    const char* cA = (const char*)g.A + (size_t)cur.pm * tstep; const char* cB = (const char*)g.Bt + (size_t)cur.pn * tstep;
    S.a_ready(cur);
    if constexpr (SP2) {
        PG8_STAGE(PG8_SB(0, 0), cB, voffB); PG8_STAGE(PG8_SB(0, 1), cB + hstep, voffB); PG8_STAGE(PG8_SA(0, 0), cA, voffA); PG8_STAGE(PG8_SA(0, 1), cA + hstep, voffA);
        if (wr == 1) PG8_BAR;
        PG8_WAIT_V(2); PG8_BAR;
        PG8_STAGE(PG8_SB(1, 0), cB + kstep, voffB); PG8_STAGE(PG8_SA(1, 0), cA + kstep, voffA); PG8_STAGE(PG8_SB(1, 1), cB + hstep + kstep, voffB);
        PG8_WAIT_V(6); PG8_BAR;
    } else {
        PG8_STAGE(PG8_SB(0, 0), cB, voffB); PG8_STAGE(PG8_SA(0, 0), cA, voffA); PG8_STAGE(PG8_SB(0, 1), cB + hstep, voffB); PG8_STAGE(PG8_SA(0, 1), cA + hstep, voffA);
        if (wr == 1) PG8_BAR;
        PG8_WAIT_V(4); PG8_BAR;
        PG8_STAGE(PG8_SB(1, 0), cB + kstep, voffB); PG8_STAGE(PG8_SA(1, 0), cA + kstep, voffA); PG8_STAGE(PG8_SB(1, 1), cB + hstep + kstep, voffB);
        PG8_WAIT_V(6); PG8_BAR;
    }
    for (;;) {
        const bool has_next = S.next(ui + 1, nxt);
        const char* nA = has_next ? (const char*)g.A + (size_t)nxt.pm * tstep : cA; const char* nB = has_next ? (const char*)g.Bt + (size_t)nxt.pn * tstep : cB;
        for (int t = 0; t < nt; t += 2) {
            if constexpr (Epi::MID_T >= 0) { if (t == Epi::MID_T) E.mid(acc, cur, wr, wc, fr, fq); }
            const bool last = (t == nt - 2);
            const char* a1 = cA + (size_t)(t + 1) * kstep;
            const char* a2 = last ? nA : cA + (size_t)(t + 2) * kstep; const char* b2 = last ? nB : cB + (size_t)(t + 2) * kstep;
            const char* a3 = a2 + kstep; const char* b3 = b2 + kstep;
            if (last && has_next) S.a_ready(nxt);
            if constexpr (SP2) {
            PG8_LDB(B0, 0, 0); PG8_LDB(B1, 0, 1); PG8_SCHED; PG8_LDA(At, 0, 0); PG8_STAGE(PG8_SA(1, 1), a1 + hstep, voffA);
            PG8_WAIT_V(8); PG8_WAIT_L(0); PG8_BAR; PG8_MMA(0, 0, At, B0); PG8_MMA(0, 1, At, B1); PG8_BAR; PG8_SCHED;
            PG8_LDA(At, 0, 1); PG8_STAGE(PG8_SB(0, 0), b2, voffB); PG8_STAGE(PG8_SB(0, 1), b2 + hstep, voffB); PG8_STAGE(PG8_SA(0, 0), a2, voffA);
            PG8_WAIT_V(8); PG8_WAIT_L(0); PG8_BAR; PG8_MMA(1, 0, At, B0); PG8_MMA(1, 1, At, B1); PG8_BAR; PG8_SCHED;
            PG8_LDB(B0, 1, 0); PG8_LDB(B1, 1, 1); PG8_SCHED; PG8_LDA(At, 1, 0); PG8_STAGE(PG8_SA(0, 1), a2 + hstep, voffA);
            PG8_WAIT_V(8); PG8_WAIT_L(0); PG8_BAR; PG8_MMA(0, 0, At, B0); PG8_MMA(0, 1, At, B1); PG8_BAR; PG8_SCHED;
            PG8_LDA(At, 1, 1); PG8_STAGE(PG8_SB(1, 0), b3, voffB); PG8_STAGE(PG8_SB(1, 1), b3 + hstep, voffB); PG8_STAGE(PG8_SA(1, 0), a3, voffA);
            PG8_WAIT_V(8); PG8_WAIT_L(0); PG8_BAR; PG8_MMA(1, 0, At, B0); PG8_MMA(1, 1, At, B1); PG8_BAR; PG8_SCHED;
            } else {
            PG8_LDB(B0, 0, 0); PG8_SCHED; PG8_LDA(At, 0, 0); PG8_STAGE(PG8_SA(1, 1), a1 + hstep, voffA);
            PG8_WAIT_L(8); PG8_BAR; PG8_WAIT_L(0); PG8_MMA(0, 0, At, B0); PG8_BAR; PG8_SCHED;
            PG8_LDB(B1, 0, 1); PG8_STAGE(PG8_SB(0, 0), b2, voffB);
            PG8_BAR; PG8_WAIT_L(0); PG8_MMA(0, 1, At, B1); PG8_BAR;
            PG8_LDA(At, 0, 1); PG8_STAGE(PG8_SA(0, 0), a2, voffA);
            PG8_BAR; PG8_WAIT_L(0); PG8_MMA(1, 0, At, B0); PG8_BAR; PG8_SCHED;
            PG8_STAGE(PG8_SB(0, 1), b2 + hstep, voffB);
            PG8_WAIT_V(6); PG8_BAR; PG8_MMA(1, 1, At, B1); PG8_BAR;
            PG8_LDB(B0, 1, 0); PG8_SCHED; PG8_LDA(At, 1, 0); PG8_STAGE(PG8_SA(0, 1), a2 + hstep, voffA);
            PG8_WAIT_L(8); PG8_BAR; PG8_WAIT_L(0); PG8_MMA(0, 0, At, B0); PG8_BAR; PG8_SCHED;
            PG8_LDB(B1, 1, 1); PG8_STAGE(PG8_SB(1, 0), b3, voffB);
            PG8_BAR; PG8_WAIT_L(0); PG8_MMA(0, 1, At, B1); PG8_BAR;
            PG8_LDA(At, 1, 1); PG8_STAGE(PG8_SA(1, 0), a3, voffA);
            PG8_BAR; PG8_WAIT_L(0); PG8_MMA(1, 0, At, B0); PG8_BAR; PG8_SCHED;
            PG8_STAGE(PG8_SB(1, 1), b3 + hstep, voffB);
            PG8_WAIT_V(6); PG8_BAR; PG8_MMA(1, 1, At, B1); PG8_BAR;
            }
        }
        if constexpr (ALIGN_EPI) { if (wr == 0) PG8_BAR; }
        if constexpr (!Epi::AFTER_DRAIN) { E(acc, cur, wr, wc, fr, fq);
#ifdef PROBE_EPI2
            if constexpr (Epi::IDEMPOTENT) { asm volatile("" ::: "memory"); E(acc, cur, wr, wc, fr, fq); }
#endif
            S.done(cur); }
        if (!has_next) break;
#pragma unroll
        for (int a = 0; a < 2; ++a)
#pragma unroll
            for (int b = 0; b < 2; ++b)
#pragma unroll
                for (int m = 0; m < 4; ++m)
#pragma unroll
                    for (int n = 0; n < 2; ++n) acc[a][b][m][n] = (f32x4){0.f, 0.f, 0.f, 0.f};
        cur = nxt; cA = nA; cB = nB; ++ui;
        if constexpr (ALIGN_EPI) { if (wr == 1) PG8_BAR; }
    }
    PG8_WAIT_V(0);
    if constexpr (!ALIGN_EPI) { if (wr == 0) PG8_BAR; }
    PG8_BAR;
    if constexpr (Epi::AFTER_DRAIN) { E.fused(acc, cur, wr, wc, fr, fq, lds, wid, lane); S.done(cur); }
#undef PG8_SA
#undef PG8_SB
#undef PG8_STAGE
#undef PG8_LDA
#undef PG8_LDB
#undef PG8_MMA
#undef PG8_WAIT_V
#undef PG8_WAIT_L
#undef PG8_BAR
#undef PG8_SCHED
}
}
namespace att {
typedef short bf16x8 __attribute__((ext_vector_type(8)));
typedef short s16x4 __attribute__((ext_vector_type(4)));
typedef float f32x16 __attribute__((ext_vector_type(16)));
typedef float f32x4 __attribute__((ext_vector_type(4)));
typedef unsigned u32x4 __attribute__((ext_vector_type(4)));
typedef unsigned short bf16_t;
#define ALAS __attribute__((address_space(3)))
constexpr int SEQ = 2048, LDQ = 2816;
constexpr int SLOTB = 8192;
constexpr int L_K = 0, L_V = 2 * SLOTB, L_WS = 4 * SLOTB, L_OST = L_WS + 8 * 256, L_END = L_OST + 8 * 4096;
constexpr int L_SC = 0, L_MASK = 131072, L_WL = 131072 + 8192;

__device__ __forceinline__ int crow(int r, int hi) { return (r & 3) + 8 * (r >> 2) + 4 * hi; }
__device__ __forceinline__ unsigned cvtpk(float lo, float hi) { return pg8::cvt_pk_bf16(lo, hi); }
__device__ __forceinline__ float other_half(float mine) {
    const unsigned mb = __float_as_uint(mine);
    auto rr = __builtin_amdgcn_permlane32_swap(mb, mb, false, false);
    return __uint_as_float(rr[0] == mb ? rr[1] : rr[0]);
}
__device__ __forceinline__ float both_sum(float mine) { const unsigned mb = __float_as_uint(mine); auto rr = __builtin_amdgcn_permlane32_swap(mb, mb, false, false); return __uint_as_float(rr[0]) + __uint_as_float(rr[1]); }
__device__ __forceinline__ float both_max(float mine) { const unsigned mb = __float_as_uint(mine); auto rr = __builtin_amdgcn_permlane32_swap(mb, mb, false, false); return fmaxf(__uint_as_float(rr[0]), __uint_as_float(rr[1])); }
__device__ __forceinline__ void both_vals(float mine, float& lo, float& up) { const unsigned mb = __float_as_uint(mine); auto rr = __builtin_amdgcn_permlane32_swap(mb, mb, false, false); lo = __uint_as_float(rr[0]); up = __uint_as_float(rr[1]); }
__device__ __forceinline__ void qkt(f32x16& p0, f32x16& p1, const ALAS char* Kslot, const bf16x8* qr, int r32, int hi) {
    const ALAS char* kb = Kslot + hi * 1024 + r32 * 16;
    p0 = f32x16{}; p1 = f32x16{};
#pragma unroll
    for (int d0 = 0; d0 < 4; ++d0) {
        const bf16x8 b0 = *(const ALAS bf16x8*)(kb + d0 * 2048);
        const bf16x8 b1 = *(const ALAS bf16x8*)(kb + d0 * 2048 + 512);
        p0 = __builtin_amdgcn_mfma_f32_32x32x16_bf16(b0, qr[d0], p0, 0, 0, 0);
        p1 = __builtin_amdgcn_mfma_f32_32x32x16_bf16(b1, qr[d0], p1, 0, 0, 0);
    }
}
__device__ __forceinline__ void qkt_c(f32x16& p0, f32x16& p1, const ALAS char* Kslot, const bf16x8* qr, const f32x16& c0, int r32, int hi) {
    const ALAS char* kb = Kslot + hi * 1024 + r32 * 16;
#pragma unroll
    for (int d0 = 0; d0 < 4; ++d0) {
        const bf16x8 b0 = *(const ALAS bf16x8*)(kb + d0 * 2048);
        const bf16x8 b1 = *(const ALAS bf16x8*)(kb + d0 * 2048 + 512);
        if (d0 == 0) { p0 = __builtin_amdgcn_mfma_f32_32x32x16_bf16(b0, qr[0], c0, 0, 0, 0); p1 = __builtin_amdgcn_mfma_f32_32x32x16_bf16(b1, qr[0], c0, 0, 0, 0); }
        else { p0 = __builtin_amdgcn_mfma_f32_32x32x16_bf16(b0, qr[d0], p0, 0, 0, 0); p1 = __builtin_amdgcn_mfma_f32_32x32x16_bf16(b1, qr[d0], p1, 0, 0, 0); }
    }
}
__device__ __forceinline__ void pv(f32x16* o, int vb, bf16x8 pa0, bf16x8 pa1, bf16x8 pa2, bf16x8 pa3) {
#pragma unroll
    for (int d0 = 0; d0 < 2; ++d0) { s16x4 lo[4], hi[4];
#pragma unroll
        for (int ks = 0; ks < 4; ++ks) {
            asm volatile("ds_read_b64_tr_b16 %0,%1 offset:%c2" : "=&v"(lo[ks]) : "v"(vb), "i"(d0 * 4096 + ks * 1024) : "memory");
            asm volatile("ds_read_b64_tr_b16 %0,%1 offset:%c2" : "=&v"(hi[ks]) : "v"(vb), "i"(d0 * 4096 + ks * 1024 + 512) : "memory"); }
        asm volatile("s_waitcnt lgkmcnt(0)" ::: "memory"); __builtin_amdgcn_sched_barrier(0);
#define PK(k) (bf16x8){lo[k][0], lo[k][1], lo[k][2], lo[k][3], hi[k][0], hi[k][1], hi[k][2], hi[k][3]}
        o[d0] = __builtin_amdgcn_mfma_f32_32x32x16_bf16(pa0, PK(0), o[d0], 0, 0, 0);
        o[d0] = __builtin_amdgcn_mfma_f32_32x32x16_bf16(pa1, PK(1), o[d0], 0, 0, 0);
        o[d0] = __builtin_amdgcn_mfma_f32_32x32x16_bf16(pa2, PK(2), o[d0], 0, 0, 0);
        o[d0] = __builtin_amdgcn_mfma_f32_32x32x16_bf16(pa3, PK(3), o[d0], 0, 0, 0);
#undef PK
    }
}
#define PKP(P, B) cvtpk(P[B], P[B + 1])
__device__ __forceinline__ void pv_from(f32x16* o, int vb, const f32x16& p0, const f32x16& p1) {
    const u32x4 pw0 = (u32x4){PKP(p0, 0), PKP(p0, 2), PKP(p0, 4), PKP(p0, 6)}, pw1 = (u32x4){PKP(p0, 8), PKP(p0, 10), PKP(p0, 12), PKP(p0, 14)};
    const u32x4 pw2 = (u32x4){PKP(p1, 0), PKP(p1, 2), PKP(p1, 4), PKP(p1, 6)}, pw3 = (u32x4){PKP(p1, 8), PKP(p1, 10), PKP(p1, 12), PKP(p1, 14)};
    pv(o, vb, __builtin_bit_cast(bf16x8, pw0), __builtin_bit_cast(bf16x8, pw1), __builtin_bit_cast(bf16x8, pw2), __builtin_bit_cast(bf16x8, pw3));
}
#undef PKP
__device__ __forceinline__ void store_o(const f32x16* o, const float* rscale, ALAS char* shm, bf16_t* Yw, int ldy, int wid, int lane, int r32, int hi) {
    ALAS bf16_t* stg = (ALAS bf16_t*)(shm + L_OST) + wid * 2048;
#pragma unroll
    for (int r = 0; r < 16; ++r) { const int orow = crow(r, hi);
#pragma unroll
        for (int d0 = 0; d0 < 2; ++d0) { const float v = o[d0][r] * rscale[r]; stg[orow * 64 + d0 * 32 + r32] = (bf16_t)(cvtpk(v, v) & 0xffffu); } }
    asm volatile("s_waitcnt lgkmcnt(0)" ::: "memory");
#pragma unroll
    for (int i = 0; i < 4; ++i) { const int row = i * 8 + (lane >> 3), ch = lane & 7; const u32x4 v = *(const ALAS u32x4*)(stg + row * 64 + ch * 8); *(u32x4*)(Yw + (size_t)row * ldy + ch * 8) = v; }
    asm volatile("s_waitcnt lgkmcnt(0)" ::: "memory");
}

struct SbPre { bf16x8 qr[4]; u32x4 kreg, vreg; };
__device__ __forceinline__ void sb_prefetch(SbPre& P, int b, int h, int qb, const bf16_t* QKV, const int wid, const int lane) {
    const int r32 = lane & 31, hi = lane >> 5; const size_t rowbase = (size_t)b * SEQ; const int q0 = qb * 256; const int NT = (q0 + 256) / 64;
    const bf16_t* Qw = QKV + (rowbase + q0 + wid * 32) * LDQ + h * 64;
    const bf16_t* ksrc = QKV + rowbase * LDQ + 512 + h * 64 + (size_t)lane * LDQ + wid * 8;
    const bf16_t* vsrc = QKV + rowbase * LDQ + 1024 + h * 64 + (size_t)(16 * (wid & 3) + (lane >> 2)) * LDQ + (wid >> 2) * 32 + (lane & 3) * 8;
#pragma unroll
    for (int d0 = 0; d0 < 4; ++d0) P.qr[d0] = *(const bf16x8*)(Qw + (size_t)r32 * LDQ + d0 * 16 + hi * 8);
    P.kreg = *(const u32x4*)(ksrc + (size_t)(NT - 1) * 64 * LDQ); P.vreg = *(const u32x4*)(vsrc + (size_t)(NT - 1) * 64 * LDQ);
}
__device__ __forceinline__ void sb_unit(int b, int h, int qb, const bf16_t* QKV, bf16_t* Y, ALAS char* shm, const int wid, SbPre& P, bool has_next, int nb, int nh, int nqb) {
    const int lane = mk_lane(), tid = wid * 64 + lane, r32 = lane & 31, hi = lane >> 5;
    const size_t rowbase = (size_t)b * SEQ; const int q0 = qb * 256;
    const bf16_t* Qw = QKV + (rowbase + q0 + wid * 32) * LDQ + h * 64;
    const bf16_t* Kh = QKV + rowbase * LDQ + 512 + h * 64; const bf16_t* Vh = QKV + rowbase * LDQ + 1024 + h * 64;
    const bf16_t* ksrc = Kh + (size_t)lane * LDQ + wid * 8;
    const bf16_t* vsrc = Vh + (size_t)(16 * (wid & 3) + (lane >> 2)) * LDQ + (wid >> 2) * 32 + (lane & 3) * 8;
    const int stoff = wid * 1024 + lane * 16;
    const int vb0 = (int)(unsigned)(uintptr_t)(shm + L_V) + ((lane >> 4) & 1) * 32 + (lane & 3) * 8 + (4 * hi + ((lane & 15) >> 2)) * 64;
    ALAS unsigned* flags = (ALAS unsigned*)(shm + L_WS);
    bf16x8 qr[4];
#pragma unroll
    for (int d0 = 0; d0 < 4; ++d0) qr[d0] = P.qr[d0];
    const int NT = (q0 + 256) / 64;
    const int myt = q0 + wid * 32 + r32, wmax = q0 + wid * 32 + 31, wmin = q0 + wid * 32;
    float carry = 1.f; f32x16 o[2]; o[0] = f32x16{}; o[1] = f32x16{};
    u32x4 kreg = P.kreg, vreg = P.vreg;
    int slot = 0; bool alive = true;
    for (int jt = NT - 1; jt >= 0; --jt) {
        *(ALAS u32x4*)(shm + L_K + slot * SLOTB + stoff) = kreg; *(ALAS u32x4*)(shm + L_V + slot * SLOTB + stoff) = vreg;
        if (lane == 0) flags[slot * 8 + wid] = alive ? 1u : 0u;
        __syncthreads();
        { const u32x4 f0 = *(const ALAS u32x4*)(flags + slot * 8), f1 = *(const ALAS u32x4*)(flags + slot * 8 + 4);
          if (((f0.x | f0.y) | (f0.z | f0.w) | (f1.x | f1.y) | (f1.z | f1.w)) == 0u) break; }
        if (jt > 0) { kreg = *(const u32x4*)(ksrc + (size_t)(jt - 1) * 64 * LDQ); vreg = *(const u32x4*)(vsrc + (size_t)(jt - 1) * 64 * LDQ); }
        if (alive && 64 * jt < wmax) {
            f32x16 p0, p1; qkt(p0, p1, shm + L_K + slot * SLOTB, qr, r32, hi);
            const bool diag = (64 * jt + 63 >= wmin);
            f32x16 l0, l1;
            if (diag) {
#pragma unroll
                for (int r = 0; r < 16; ++r) {
                    { const float e = __builtin_amdgcn_exp2f(fminf(p0[r], 80.f)); float kp = __builtin_amdgcn_rcpf(1.0f + e); float be = e * kp;
                      if (!(64 * jt + crow(r, hi) < myt)) { kp = 1.f; be = 0.f; } l0[r] = kp; p0[r] = be; }
                    { const float e = __builtin_amdgcn_exp2f(fminf(p1[r], 80.f)); float kp = __builtin_amdgcn_rcpf(1.0f + e); float be = e * kp;
                      if (!(64 * jt + 32 + crow(r, hi) < myt)) { kp = 1.f; be = 0.f; } l1[r] = kp; p1[r] = be; }
                }
            } else {
#pragma unroll
                for (int r = 0; r < 16; ++r) {
                    { const float e = __builtin_amdgcn_exp2f(fminf(p0[r], 80.f)); const float kp = __builtin_amdgcn_rcpf(1.0f + e); l0[r] = kp; p0[r] = e * kp; }
                    { const float e = __builtin_amdgcn_exp2f(fminf(p1[r], 80.f)); const float kp = __builtin_amdgcn_rcpf(1.0f + e); l1[r] = kp; p1[r] = e * kp; }
                }
            }
            float run = carry;
#pragma unroll
            for (int g = 3; g >= 0; --g) {
                const float tm = (l1[4 * g] * l1[4 * g + 1]) * (l1[4 * g + 2] * l1[4 * g + 3]); float t0, t1; both_vals(tm, t0, t1);
                float pre = hi ? run : run * t1;
                p1[4 * g + 3] *= pre; pre *= l1[4 * g + 3]; p1[4 * g + 2] *= pre; pre *= l1[4 * g + 2]; p1[4 * g + 1] *= pre; pre *= l1[4 * g + 1]; p1[4 * g] *= pre;
                run = (run * t1) * t0;
            }
#pragma unroll
            for (int g = 3; g >= 0; --g) {
                const float tm = (l0[4 * g] * l0[4 * g + 1]) * (l0[4 * g + 2] * l0[4 * g + 3]); float t0, t1; both_vals(tm, t0, t1);
                float pre = hi ? run : run * t1;
                p0[4 * g + 3] *= pre; pre *= l0[4 * g + 3]; p0[4 * g + 2] *= pre; pre *= l0[4 * g + 2]; p0[4 * g + 1] *= pre; pre *= l0[4 * g + 1]; p0[4 * g] *= pre;
                run = (run * t1) * t0;
            }
            carry = run;
            pv_from(o, vb0 + slot * SLOTB, p0, p1);
            alive = !__all(carry == 0.f);
        }
        slot ^= 1;
    }
    if (has_next) sb_prefetch(P, nb, nh, nqb, QKV, wid, lane);
    float ones[16];
#pragma unroll
    for (int r = 0; r < 16; ++r) ones[r] = 1.0f;
    __syncthreads();
    store_o(o, ones, shm, Y + (rowbase + q0 + wid * 32) * 1024 + h * 64, 1024, wid, lane, r32, hi);
    __syncthreads();
}

__device__ __forceinline__ int cnt_ge8(const unsigned* u, unsigned c) {
    unsigned long long m0, m1, m2, m3, m4, m5, m6, m7;
    asm("v_cmp_ge_u32_e64 %0, %8, %16\n\tv_cmp_ge_u32_e64 %1, %9, %16\n\tv_cmp_ge_u32_e64 %2, %10, %16\n\tv_cmp_ge_u32_e64 %3, %11, %16\n\t"
        "v_cmp_ge_u32_e64 %4, %12, %16\n\tv_cmp_ge_u32_e64 %5, %13, %16\n\tv_cmp_ge_u32_e64 %6, %14, %16\n\tv_cmp_ge_u32_e64 %7, %15, %16"
        : "=&s"(m0), "=&s"(m1), "=&s"(m2), "=&s"(m3), "=&s"(m4), "=&s"(m5), "=&s"(m6), "=&s"(m7)
        : "v"(u[0]), "v"(u[1]), "v"(u[2]), "v"(u[3]), "v"(u[4]), "v"(u[5]), "v"(u[6]), "v"(u[7]), "v"(c));
    return (int)((__builtin_popcountll(m0) + __builtin_popcountll(m1)) + (__builtin_popcountll(m2) + __builtin_popcountll(m3)))
         + (int)((__builtin_popcountll(m4) + __builtin_popcountll(m5)) + (__builtin_popcountll(m6) + __builtin_popcountll(m7)));
}
__device__ __forceinline__ unsigned mono(float f) { const unsigned u = __float_as_uint(f + 0.0f); return u ^ ((u >> 31) ? 0xffffffffu : 0x80000000u); }
#define DPPI(v, ctrl) __builtin_amdgcn_update_dpp(0, (v), (ctrl), 0xf, 0xf, true)
#define DPPK(v, ctrl) __builtin_amdgcn_update_dpp((v), (v), (ctrl), 0xf, 0xf, false)
__device__ __forceinline__ int wave_incl_scan(int v, int lane) {
    v += DPPI(v, 0x111); v += DPPI(v, 0x112); v += DPPI(v, 0x114); v += DPPI(v, 0x118);
    const int t0 = __builtin_amdgcn_readlane(v, 15), t1 = __builtin_amdgcn_readlane(v, 31), t2 = __builtin_amdgcn_readlane(v, 47);
    const int row = lane >> 4; return v + (row >= 1 ? t0 : 0) + (row >= 2 ? t1 : 0) + (row >= 3 ? t2 : 0);
}
__device__ __forceinline__ int wave_max_i(int v) {
    v = max(v, DPPK(v, 0xB1)); v = max(v, DPPK(v, 0x4E)); v = max(v, DPPK(v, 0x124)); v = max(v, DPPK(v, 0x128));
    return max(max(__builtin_amdgcn_readlane(v, 0), __builtin_amdgcn_readlane(v, 16)), max(__builtin_amdgcn_readlane(v, 32), __builtin_amdgcn_readlane(v, 48)));
}
__device__ __forceinline__ float wave_max_f(float x) {
    int v = __float_as_int(x);
#define FMX(a, b) __float_as_int(fmaxf(__int_as_float(a), __int_as_float(b)))
    v = FMX(v, DPPK(v, 0xB1)); v = FMX(v, DPPK(v, 0x4E)); v = FMX(v, DPPK(v, 0x124)); v = FMX(v, DPPK(v, 0x128));
    const float r = fmaxf(fmaxf(__int_as_float(__builtin_amdgcn_readlane(v, 0)), __int_as_float(__builtin_amdgcn_readlane(v, 16))), fmaxf(__int_as_float(__builtin_amdgcn_readlane(v, 32)), __int_as_float(__builtin_amdgcn_readlane(v, 48))));
#undef FMX
    return r;
}
constexpr int L_HIST = 143360, L_CAND = 151552;
__device__ __forceinline__ void idx_load_aq(bf16x8 (&aq)[4][4], size_t rowbase, int qs0, const bf16_t* QKV, int r32, int hi) {
#pragma unroll
    for (int mt = 0; mt < 4; ++mt)
#pragma unroll
        for (int d0 = 0; d0 < 4; ++d0) aq[mt][d0] = *(const bf16x8*)(QKV + (rowbase + qs0 + 4 * mt + (r32 >> 3)) * LDQ + 2048 + (r32 & 7) * 64 + d0 * 16 + hi * 8);
}
__device__ __forceinline__ void idx_score16(const bf16x8 (&aq)[4][4], int b, int qs0, int qslot0, const bf16_t* QKV, ALAS char* shm, const int wid) {

    const int lane = mk_lane(), tid = wid * 64 + lane, r32 = lane & 31, hi = lane >> 5;
    const size_t rowbase = (size_t)b * SEQ;
    ALAS float* sc = (ALAS float*)(shm + L_SC); ALAS float* wl = (ALAS float*)(shm + L_WL) + qslot0 * 8; ALAS unsigned long long* maskL = (ALAS unsigned long long*)(shm + L_MASK);
    const int nkt = (qs0 + 15) / 32 + 1;
    {
    bf16x8 bkn[4];
    { const int kt0 = wid < nkt ? wid : 0;
#pragma unroll
      for (int d0 = 0; d0 < 4; ++d0) bkn[d0] = *(const bf16x8*)(QKV + (rowbase + 32 * kt0 + r32) * LDQ + 2688 + d0 * 16 + hi * 8); }
#ifdef REP_SCORE
#pragma unroll 1
    for (int rep_ = 0; rep_ < REP_SCORE; ++rep_)
#endif
    for (int kt = wid; kt < nkt; kt += 8) {
        bf16x8 bk[4];
#pragma unroll
        for (int d0 = 0; d0 < 4; ++d0) bk[d0] = bkn[d0];
        { const int ktn = kt + 8 < nkt ? kt + 8 : kt;
#pragma unroll
          for (int d0 = 0; d0 < 4; ++d0) bkn[d0] = *(const bf16x8*)(QKV + (rowbase + 32 * ktn + r32) * LDQ + 2688 + d0 * 16 + hi * 8); }
#pragma unroll
        for (int mt = 0; mt < 4; ++mt) {
            f32x16 c = f32x16{};
#pragma unroll
            for (int d0 = 0; d0 < 4; ++d0) c = __builtin_amdgcn_mfma_f32_32x32x16_bf16(aq[mt][d0], bk[d0], c, 0, 0, 0);
            float pq[4];
#pragma unroll
            for (int ql = 0; ql < 4; ++ql) {
                const f32x4 w4 = *(const ALAS f32x4*)(wl + (4 * mt + ql) * 8 + 4 * hi);
                float part = w4[0] * fmaxf(c[4 * ql], 0.f); part += w4[1] * fmaxf(c[4 * ql + 1], 0.f); part += w4[2] * fmaxf(c[4 * ql + 2], 0.f); part += w4[3] * fmaxf(c[4 * ql + 3], 0.f);
                pq[ql] = part;
            }
#pragma unroll
            for (int pr = 0; pr < 2; ++pr) {
                auto rr = __builtin_amdgcn_permlane32_swap(__float_as_uint(pq[2 * pr]), __float_as_uint(pq[2 * pr + 1]), false, false);
                sc[(4 * mt + 2 * pr + hi) * 2048 + 32 * kt + r32] = __uint_as_float(rr[0]) + __uint_as_float(rr[1]);
            }
        }
    }
    }
}
__device__ __forceinline__ void idx_sel16(int b, int qs0, int qslot0, int NTW, ALAS char* shm, const int wid) {

    const int lane = mk_lane(), tid = wid * 64 + lane, r32 = lane & 31, hi = lane >> 5;
    const size_t rowbase = (size_t)b * SEQ;
    ALAS float* sc = (ALAS float*)(shm + L_SC); ALAS float* wl = (ALAS float*)(shm + L_WL) + qslot0 * 8; ALAS unsigned long long* maskL = (ALAS unsigned long long*)(shm + L_MASK);
#ifdef REP_SEL
#pragma unroll 1
    for (int rep_ = 0; rep_ < REP_SEL; ++rep_)
#endif
#pragma unroll 1
    for (int qq = 0; qq < 2; ++qq) {
        const int q = 2 * wid + qq, t = qs0 + q; const int qs = qslot0 + q;
        if (t < 256) {
            for (int i = 0; i < NTW; ++i) { const unsigned long long w = __ballot(64 * i + lane <= t); if (lane == 0) maskL[i * 32 + qs] = w; }
        } else {
            float f[32]; int bq[32];
            const int nreg = (t >> 6) + 1;
            float lmin = 3.0e38f, lmax = -3.0e38f;
#pragma unroll
            for (int i = 0; i < 32; ++i) { f[i] = 0.f; bq[i] = -1; }
#pragma unroll
            for (int blk = 0; blk < 4; ++blk) if (8 * blk < nreg) {
#pragma unroll
                for (int i = 8 * blk; i < 8 * blk + 8; ++i) { const int key = lane + 64 * i; const bool valid = key <= t; f[i] = sc[q * 2048 + key] + 0.0f;
                    lmin = fminf(lmin, valid ? f[i] : 3.0e38f); lmax = fmaxf(lmax, valid ? f[i] : -3.0e38f); } }
            const float smax = wave_max_f(lmax), smin = -wave_max_f(-lmin);
            const float scale = smax > smin ? 255.99f / (smax - smin) : 0.f;
            ALAS unsigned* hist = (ALAS unsigned*)(shm + L_HIST) + wid * 256;
            *(ALAS u32x4*)(hist + 4 * lane) = (u32x4){0u, 0u, 0u, 0u};
#pragma unroll
            for (int blk = 0; blk < 4; ++blk) if (8 * blk < nreg) {
#pragma unroll
                for (int i = 8 * blk; i < 8 * blk + 8; ++i) { const int key = lane + 64 * i; const bool valid = key <= t;
                    int bi = (int)((f[i] - smin) * scale); bi = bi > 255 ? 255 : bi; bq[i] = valid ? bi : -1;
                    if (valid) __hip_atomic_fetch_add(hist + bi, 1u, __ATOMIC_RELAXED, __HIP_MEMORY_SCOPE_WORKGROUP); } }
            const u32x4 c4 = *(const ALAS u32x4*)(hist + 4 * lane);
            const int lsum4 = (int)(c4.x + c4.y + c4.z + c4.w);
            const int pin = wave_incl_scan(lsum4, lane); const int total = __builtin_amdgcn_readlane(pin, 63);
            const int S3 = total - pin + (int)c4.w, S2 = S3 + (int)c4.z, S1 = S2 + (int)c4.y, S0 = S1 + (int)c4.x;
            const int bl = S3 >= 256 ? 4 * lane + 3 : S2 >= 256 ? 4 * lane + 2 : S1 >= 256 ? 4 * lane + 1 : S0 >= 256 ? 4 * lane : -1;
            const int bstar = wave_max_i(bl);
            const int jb = bstar & 3;
            const int Sj = jb == 3 ? S3 : jb == 2 ? S2 : jb == 1 ? S1 : S0, cj = (int)(jb == 3 ? c4.w : jb == 2 ? c4.z : jb == 1 ? c4.y : c4.x);
            const int C = __builtin_amdgcn_readlane(cj, bstar >> 2), need = 256 - (__builtin_amdgcn_readlane(Sj, bstar >> 2) - C);
            if (C <= 64) {
                ALAS float* cs = (ALAS float*)(shm + L_CAND) + wid * 128; ALAS int* ck = (ALAS int*)(cs + 64);
                int cl = 0;
#pragma unroll
                for (int i = 0; i < 32; ++i) cl += (bq[i] == bstar) ? 1 : 0;
                int pos = wave_incl_scan(cl, lane) - cl;
                unsigned wlo = 0u, whi = 0u;
#pragma unroll
                for (int blk = 0; blk < 4; ++blk) if (8 * blk < nreg) {
#pragma unroll
                    for (int i = 8 * blk; i < 8 * blk + 8; ++i) {
                        if (bq[i] == bstar) { cs[pos] = f[i]; ck[pos] = lane + 64 * i; ++pos; }
                        const unsigned long long w = __ballot(bq[i] > bstar);
                        asm volatile("s_nop 4\n\tv_writelane_b32 %0, %2, %4\n\tv_writelane_b32 %1, %3, %4" : "+v"(wlo), "+v"(whi) : "s"((unsigned)w), "s"((unsigned)(w >> 32)), "n"(i)); } }
                if (lane < NTW) maskL[lane * 32 + qs] = ((unsigned long long)whi << 32) | wlo;
                const int jl = lane < C ? lane : 0; const float sj = cs[jl]; const int kj = ck[jl];
                int rank = 0;
                for (int m = 0; m < C; ++m) { const float sm = cs[m]; const int km = ck[m]; rank += (sm > sj || (sm == sj && km < kj)) ? 1 : 0; }
                if (lane < C && rank < need)
                    __hip_atomic_fetch_or((ALAS unsigned*)maskL + (((kj >> 6) * 32 + qs) * 2 + ((kj >> 5) & 1)), 1u << (kj & 31), __ATOMIC_RELAXED, __HIP_MEMORY_SCOPE_WORKGROUP);
            } else {
            unsigned u[32];
#pragma unroll
            for (int i = 0; i < 32; ++i) { const int key = lane + 64 * i; u[i] = (key <= t) ? mono(f[i]) : 0u; }
            unsigned thr = 0u; bool exact = false;
#pragma unroll 1
            for (int bit = 31; bit >= 0; --bit) {
                const unsigned cand = thr | (1u << bit);
                int cnt = cnt_ge8(u, cand);
                if (nreg > 8) cnt += cnt_ge8(u + 8, cand);
                if (nreg > 16) cnt += cnt_ge8(u + 16, cand);
                if (nreg > 24) cnt += cnt_ge8(u + 24, cand);
                if (cnt >= 256) { thr = cand; if (cnt == 256) { exact = true; break; } }
            }
            int need = 0;
            if (!exact) { int cgt = 0;
#pragma unroll
                for (int i = 0; i < 32; ++i) cgt += __builtin_popcountll(__ballot(u[i] > thr));
                need = 256 - cgt; }
            int seen = 0;
#pragma unroll
            for (int i = 0; i < 32; ++i) {
                unsigned long long w;
                if (exact) w = __ballot(u[i] >= thr);
                else { const unsigned long long eqm = __ballot(u[i] == thr); const int rank = seen + (int)__builtin_popcountll(eqm & ((1ull << lane) - 1ull));
                       w = __ballot(u[i] > thr || (u[i] == thr && rank < need)); seen += (int)__builtin_popcountll(eqm); }
                if (i < NTW && lane == 0) maskL[i * 32 + qs] = w;
            }
            }
        }
    }
    }

struct DsPre { float wlv; };
__device__ __forceinline__ void dsa_prefetch(DsPre& P, int b, int qblk, const bf16_t* QKV, const float* wi, const int wid, const int lane) {
    const int tid = wid * 64 + lane, r32 = lane & 31, hi = lane >> 5; const size_t rowbase = (size_t)b * SEQ; const int q0 = qblk * 32;
    P.wlv = tid < 256 ? wi[(rowbase + q0) * 8 + tid] : 0.f;
}
__device__ __forceinline__ void dsa_unit(int b, int qblk, const bf16_t* QKV, const float* wi, bf16_t* Y, ALAS char* shm, const int wid, DsPre& P, bool has_next, int nb, int nqblk) {
    const int lane = mk_lane(), tid = wid * 64 + lane, r32 = lane & 31, hi = lane >> 5;
    const size_t rowbase = (size_t)b * SEQ; const int q0 = qblk * 32; const int NT = q0 / 64 + 1;
    bf16x8 aq[4][4];
    idx_load_aq(aq, rowbase, q0, QKV, r32, hi);
    if (tid < 256) ((ALAS float*)(shm + L_WL))[tid] = P.wlv;
    __syncthreads();
    idx_score16(aq, b, q0, 0, QKV, shm, wid);
    __syncthreads();
    idx_load_aq(aq, rowbase, q0 + 16, QKV, r32, hi);
    idx_sel16(b, q0, 0, NT, shm, wid);
    __syncthreads();
    idx_score16(aq, b, q0 + 16, 16, QKV, shm, wid);
    __syncthreads();
    const bf16_t* Qw = QKV + (rowbase + q0) * LDQ + 1536 + wid * 64;
    const bf16_t* Kh = QKV + rowbase * LDQ + 2560; const bf16_t* Vh = QKV + rowbase * LDQ + 2624;
    const bf16_t* ksrc = Kh + (size_t)lane * LDQ + wid * 8;
    const bf16_t* vsrc = Vh + (size_t)(16 * (wid & 3) + (lane >> 2)) * LDQ + (wid >> 2) * 32 + (lane & 3) * 8;
    bf16x8 qr[4];
#pragma unroll
    for (int d0 = 0; d0 < 4; ++d0) qr[d0] = *(const bf16x8*)(Qw + (size_t)r32 * LDQ + d0 * 16 + hi * 8);
    u32x4 kreg = *(const u32x4*)(ksrc), vreg = *(const u32x4*)(vsrc);
    idx_sel16(b, q0 + 16, 16, NT, shm, wid);
    __syncthreads();
    const ALAS unsigned long long* maskL = (const ALAS unsigned long long*)(shm + L_MASK);
    ALAS float* wsf = (ALAS float*)(shm + L_WS) + wid * 64;
    const int stoff = wid * 1024 + lane * 16;
    const int vb0 = (int)(unsigned)(uintptr_t)(shm + L_V) + ((lane >> 4) & 1) * 32 + (lane & 3) * 8 + (4 * hi + ((lane & 15) >> 2)) * 64;
    float mrun = 0.f, lsum = 0.f; bool seen = false; f32x16 o[2]; o[0] = f32x16{}; o[1] = f32x16{}; f32x16 negm = f32x16{};
    int slot = 0;
    for (int jt = 0; jt < NT; ++jt) {
        *(ALAS u32x4*)(shm + L_K + slot * SLOTB + stoff) = kreg; *(ALAS u32x4*)(shm + L_V + slot * SLOTB + stoff) = vreg;
        __syncthreads();
        if (jt + 1 < NT) { kreg = *(const u32x4*)(ksrc + (size_t)(jt + 1) * 64 * LDQ); vreg = *(const u32x4*)(vsrc + (size_t)(jt + 1) * 64 * LDQ); }
        const unsigned long long mw = maskL[jt * 32 + r32];
        const unsigned mlo = (unsigned)mw >> (4 * hi), mhi = (unsigned)(mw >> 32) >> (4 * hi);
        f32x16 p0, p1; qkt_c(p0, p1, shm + L_K + slot * SLOTB, qr, negm, r32, hi);
        float mx = -1e30f;
#pragma unroll
        for (int r = 0; r < 16; ++r) { const unsigned bitp = (r & 3) + 8 * (r >> 2);
            const unsigned s0 = (unsigned)__builtin_amdgcn_sbfe((int)mlo, bitp, 1u), s1 = (unsigned)__builtin_amdgcn_sbfe((int)mhi, bitp, 1u);
            p0[r] = __uint_as_float((__float_as_uint(p0[r]) & s0) | (0xf149f2cau & ~s0)); p1[r] = __uint_as_float((__float_as_uint(p1[r]) & s1) | (0xf149f2cau & ~s1));
            mx = fmaxf(fmaxf(mx, p0[r]), p1[r]); }
        mx = both_max(mx);
        const bool has = mx > -1e29f;
        const float dl = has ? (seen ? (mx > 8.0f ? mx : 0.f) : mx) : 0.f;
        if (__any(dl != 0.f)) {
            const float f = seen ? __builtin_amdgcn_exp2f(-dl) : 1.0f;
            lsum *= f;
            if (hi == 0) wsf[r32] = f;
            asm volatile("s_waitcnt lgkmcnt(0)" ::: "memory");
#pragma unroll
            for (int r = 0; r < 16; ++r) { const float fr = wsf[crow(r, hi)]; o[0][r] *= fr; o[1][r] *= fr; }
            mrun += dl;
#pragma unroll
            for (int r = 0; r < 16; ++r) { p0[r] -= dl; p1[r] -= dl; negm[r] = -mrun; }
        }
        seen = seen || has;
        float ps = 0.f;
#pragma unroll
        for (int r = 0; r < 16; ++r) { p0[r] = __builtin_amdgcn_exp2f(p0[r]); p1[r] = __builtin_amdgcn_exp2f(p1[r]); ps += p0[r] + p1[r]; }
        lsum += ps;
        pv_from(o, vb0 + slot * SLOTB, p0, p1);
        slot ^= 1;
    }
    if (has_next) dsa_prefetch(P, nb, nqblk, QKV, wi, wid, lane);
    lsum = both_sum(lsum);
    if (hi == 0) wsf[32 + r32] = lsum;
    asm volatile("s_waitcnt lgkmcnt(0)" ::: "memory");
    float rli[16];
#pragma unroll
    for (int r = 0; r < 16; ++r) rli[r] = __builtin_amdgcn_rcpf(wsf[32 + crow(r, hi)]);
    store_o(o, rli, shm, Y + (rowbase + q0) * 1024 + 512 + wid * 64, 1024, wid, lane, r32, hi);
    __syncthreads();
}
#undef ALAS
}
#ifndef MK_N_LAUNCHES
#define MK_N_LAUNCHES 1
#endif
#ifndef REP_SB
#define REP_SB 1
#endif
#ifndef REP_DSA
#define REP_DSA 1
#endif
#ifndef REP_P1
#define REP_P1 1
#endif
#ifndef REP_P2
#define REP_P2 1
#endif
#ifndef REP_P3
#define REP_P3 1
#endif
constexpr int NWAVES = 8, NPHASE = 11;
constexpr int T = 32768, SEQ = 2048, D = 1024, DFF = 2816, NIN = 4808, NINV = 4864, PLE = 256;
#define LAS __attribute__((address_space(3)))
typedef unsigned short bf16;
typedef unsigned v4u __attribute__((ext_vector_type(4)));
typedef float f32x4 __attribute__((ext_vector_type(4)));
constexpr size_t MiB = 1u << 20;
constexpr size_t WS_CTL = 11 * MiB, CTL_BYTES = 16384;
constexpr size_t WS_SSX = 0, WS_SS1 = 2 * MiB, WS_SS2 = 4 * MiB, WS_SS3 = 6 * MiB, WS_ROT = 8 * MiB, WS_WI = 10 * MiB;
constexpr size_t WS_W1A = 20 * MiB, WS_W2A = 31 * MiB, WS_WIN = 37 * MiB, WS_WOA = 47 * MiB, WS_WOB = 48 * MiB, WS_WOUT = 49 * MiB, WS_W1B = 51 * MiB, WS_W2B = 62 * MiB, WS_WPG = 68 * MiB, WS_WPP = 70 * MiB;
constexpr size_t WS_HB0 = 72 * MiB, WS_HB1 = 136 * MiB, WS_BIG = 200 * MiB, WS_GATES = 376 * MiB, WS_END = 504 * MiB;
constexpr int RING_BYTES = 131072, LDS_BYTES = 155648 + 4096, RTAB_OFF = 141312;
#define LDS_WAIT() asm volatile("s_waitcnt lgkmcnt(0)" ::: "memory")
__device__ __forceinline__ unsigned f2bf(float f) { unsigned u = __builtin_bit_cast(unsigned, f); return (u + 0x7fffu + ((u >> 16) & 1u)) >> 16; }
__device__ __forceinline__ unsigned pk2(float lo, float hi) { return f2bf(lo) | (f2bf(hi) << 16); }
__device__ __forceinline__ float wave_sum(float v) {
#pragma unroll
    for (int o = 1; o < 64; o <<= 1) v += __shfl_xor(v, o);
    return v;
}
__device__ __forceinline__ int rotp(int c) { return c < 8 ? 2 * c : (c < 16 ? 2 * (c - 8) + 1 : c); }
template <int MODE> __device__ __forceinline__ int vmap(int n) {
    if (MODE == 0) return n;
    if (MODE == 1) { const int j = n < DFF ? n : n - DFF; return (j >> 7) * 256 + (n < DFF ? 0 : 128) + (j & 127); }
    if (n < 1536) return n;
    if (n < 2048) { const int m = n - 1536; return 1536 + (m & ~63) + rotp(m & 63); }
    if (n < 2112) return 2560 + rotp(n - 2048);
    if (n < 2176) return 2624 + (n - 2112);
    if (n < 2688) { const int m = n - 2176; return 2048 + (m & ~63) + rotp(m & 63); }
    if (n < 2752) return 2688 + rotp(n - 2688);
    if (n < 2760) return n;
    if (n < 3784) return 2816 + (n - 2760);
    return 3840 + (n - 3784);
}
template <int MODE> __device__ __forceinline__ void transpose_item(const float* W, int K, int N, bf16* WT, const float* gain, LAS float* scr, int item, int lane, int ldk = 0, int koff = 0) {
    if (ldk == 0) ldk = K;
    const int nblk = (N + 31) / 32, kb = item / nblk, nb = item % nblk, k0 = 64 * kb, n0 = 32 * nb;
    const int nq = n0 + (lane & 7) * 4; f32x4 v[8];
#pragma unroll
    for (int i = 0; i < 8; ++i) { const int kk = 8 * i + (lane >> 3); v[i] = (f32x4){0.f, 0.f, 0.f, 0.f}; if (nq < N) v[i] = *(const f32x4*)(W + (size_t)(k0 + kk) * N + nq); }
#pragma unroll
    for (int i = 0; i < 8; ++i) { const int kk = 8 * i + (lane >> 3); if (gain) v[i] = v[i] * gain[k0 + kk];
        LAS float* d = scr + kk * 33 + (lane & 7) * 4; d[0] = v[i][0]; d[1] = v[i][1]; d[2] = v[i][2]; d[3] = v[i][3]; }
    LDS_WAIT(); asm volatile("" ::: "memory");
    const int c = lane & 7;
#pragma unroll
    for (int j = 0; j < 4; ++j) { const int nl = (lane >> 3) + 8 * j; const LAS float* s = scr + (8 * c) * 33 + nl;
        if (n0 + nl < N) { v4u o; o.x = pk2(s[0 * 33], s[1 * 33]); o.y = pk2(s[2 * 33], s[3 * 33]); o.z = pk2(s[4 * 33], s[5 * 33]); o.w = pk2(s[6 * 33], s[7 * 33]);
            *(v4u*)(WT + (size_t)vmap<MODE>(n0 + nl) * ldk + koff + k0 + 8 * c) = o; } }
    LDS_WAIT(); asm volatile("" ::: "memory");
}

#define XB_TMO      128
#define XB_XCNT(j)  (256  + 64 * (j))
#define XB_XSUB(j)  (1280 + 64 * (j))
#define XB_XGEN(j)  (2304 + 64 * (j))
#define XB_TOP      3328
#define XB_TOPGEN   3392
#define XCD_BAR_WORDS 3456
#define XB_SPIN_CAP (1u << 18)

__device__ __forceinline__ unsigned xb_ld(unsigned* p)              { return __hip_atomic_load(p, __ATOMIC_RELAXED, __HIP_MEMORY_SCOPE_AGENT); }
__device__ __forceinline__ unsigned xb_add(unsigned* p, unsigned v) { return __hip_atomic_fetch_add(p, v, __ATOMIC_RELAXED, __HIP_MEMORY_SCOPE_AGENT); }
__device__ __forceinline__ unsigned xb_xcc_id() { return (unsigned)__builtin_amdgcn_s_getreg((3 << 11) | 20) & 0xFu; }
#define XB_SPIN(cond, bar) do { unsigned _sp = 0; while (cond) { __builtin_amdgcn_s_sleep(1); \
    if ((++_sp & 255u) == 0u) { if (xb_ld(&(bar)[XB_TMO])) break; if (_sp > XB_SPIN_CAP) { atomicAdd(&(bar)[XB_TMO], 1u); break; } } } } while (0)

struct XcdBarrier {
    unsigned* bar; unsigned x;
    volatile LAS unsigned* st;
};

__device__ __forceinline__ XcdBarrier xcd_barrier_post(unsigned* bar, volatile LAS unsigned* st, bool leader) {
    XcdBarrier b; b.bar = bar; b.x = xb_xcc_id(); b.st = st;
    if (leader) (void)xb_add(&bar[XB_XCNT(b.x)], 1u);
    return b;
}
__device__ __forceinline__ void xcd_barrier_complete(unsigned* bar, unsigned x, unsigned& nloc, unsigned& nx) {
    const unsigned G = gridDim.x * gridDim.y * gridDim.z;
    unsigned sum, cnt, mine, sp = 0u;
    for (;;) {
        sum = 0u; cnt = 0u; mine = 0u;
#pragma unroll
        for (unsigned j = 0; j < 16; ++j) { const unsigned c = xb_ld(&bar[XB_XCNT(j)]); sum += c; cnt += (c > 0u) ? 1u : 0u; mine = (j == x) ? c : mine; }
        if (sum == G) break;
        __builtin_amdgcn_s_sleep(1);
        if ((++sp & 255u) == 0u) { if (xb_ld(&bar[XB_TMO])) break; if (sp > XB_SPIN_CAP) { atomicAdd(&bar[XB_TMO], 1u); break; } }
    }
    nloc = mine > 0u ? mine : 1u; nx = cnt > 0u ? cnt : 1u;
}

__device__ __forceinline__ void xcd_barrier(const XcdBarrier& b, bool leader) {
    asm volatile("s_waitcnt vmcnt(0)" ::: "memory");
    __syncthreads();
    if (leader) {
        unsigned* bar = b.bar;
        __builtin_amdgcn_s_waitcnt(0);
        unsigned nloc = b.st[0], nx = b.st[1];
        if (nloc == 0u) { xcd_barrier_complete(bar, b.x, nloc, nx); b.st[0] = nloc; b.st[1] = nx; }
        const unsigned old = xb_add(&bar[XB_XSUB(b.x)], 1u);
        const unsigned gen = old / nloc;
        if (old + 1u == (gen + 1u) * nloc) {
            __builtin_amdgcn_fence(__ATOMIC_RELEASE, "agent");
            asm volatile("s_waitcnt vmcnt(0)" ::: "memory");
            const unsigned og = xb_add(&bar[XB_TOP], 1u);
            const unsigned tg = og / nx;
            if (og + 1u == (tg + 1u) * nx) xb_add(&bar[XB_TOPGEN], 1u);
            else XB_SPIN(xb_ld(&bar[XB_TOPGEN]) == tg, bar);
            __builtin_amdgcn_fence(__ATOMIC_ACQUIRE, "agent");
            xb_add(&bar[XB_XGEN(b.x)], 1u);
            asm volatile("s_waitcnt vmcnt(0)" ::: "memory");
        } else {
            XB_SPIN(xb_ld(&bar[XB_XGEN(b.x)]) == gen, bar);
            __builtin_amdgcn_fence(__ATOMIC_ACQUIRE, "agent");
            asm volatile("s_waitcnt vmcnt(0)" ::: "memory");
        }
    }
    __syncthreads();
}

struct Args { const float* in[18]; float* out; unsigned char* ws; float inv_freq[8]; int ph_lo, ph_hi; };

__global__ void __launch_bounds__(NWAVES * 64, 2) mk_fwd(Args args) {
    extern __shared__ __attribute__((aligned(16))) unsigned char lds_raw[];
    LAS unsigned char* lds = (LAS unsigned char*)lds_raw;
    int wave_ = __builtin_amdgcn_readfirstlane(threadIdx.x >> 6); asm volatile("" : "+s"(wave_)); const int wave = wave_;
#define tid (wave * 64 + mk_lane())
#define lane mk_lane()
    const int G = gridDim.x, bx = blockIdx.x; const int vcu = (G % 8 == 0) ? (bx % 8) * (G / 8) + bx / 8 : bx;
    unsigned char* ws = args.ws;
    const float* x = args.in[0]; const float* pin = args.in[1]; const int* positions = (const int*)args.in[2];
    float* out = args.out;
    float* ssx = (float*)(ws + WS_SSX); float* ss1 = (float*)(ws + WS_SS1); float* ss2 = (float*)(ws + WS_SS2); float* ss3 = (float*)(ws + WS_SS3);
    float* rot = (float*)(ws + WS_ROT); float* wi = (float*)(ws + WS_WI);
    bf16 *W1a = (bf16*)(ws + WS_W1A), *W2a = (bf16*)(ws + WS_W2A), *Win = (bf16*)(ws + WS_WIN), *WoA = (bf16*)(ws + WS_WOA), *WoB = (bf16*)(ws + WS_WOB), *Wout = (bf16*)(ws + WS_WOUT);
    bf16 *W1b = (bf16*)(ws + WS_W1B), *W2b = (bf16*)(ws + WS_W2B), *Wpg = (bf16*)(ws + WS_WPG), *Wpp = (bf16*)(ws + WS_WPP);
    bf16 *HB0 = (bf16*)(ws + WS_HB0), *HB1 = (bf16*)(ws + WS_HB1), *BIG = (bf16*)(ws + WS_BIG), *GATES = (bf16*)(ws + WS_GATES);
    bf16 *ysb = HB0, *ydsa = HB0;
    bf16 *tmpb = BIG, *mergedb = BIG + (size_t)T * 1024;
    bf16 *AC = GATES;
    if (args.ph_lo == -12345) cg::this_grid().sync();
    volatile LAS unsigned* xst = (volatile LAS unsigned*)(lds + 140288);
    if (wave == 0 && mk_lane() == 0) { xst[0] = 0u; xst[1] = 0u; }
    __syncthreads();
    XcdBarrier xbar = xcd_barrier_post((unsigned*)(ws + WS_CTL), xst, wave == 0 && mk_lane() == 0);
    const int lo = args.ph_lo, hi = args.ph_hi;
#ifndef PHASE_MASK
#define PHASE_MASK 0x7ff
#endif
#define IN(k) (((PHASE_MASK >> (k)) & 1) && lo <= (k) && (k) < hi)
#define SEAM(k) do { if (IN(k) && IN((k) + 1)) xcd_barrier(xbar, wave == 0 && mk_lane() == 0); } while (0)
    const int gw = vcu * NWAVES + wave, NGW = G * NWAVES;
    const int gt = vcu * NWAVES * 64 + tid, NGT = G * NWAVES * 64;

    if (IN(0)) {
        LAS float* scr = (LAS float*)(lds + wave * 16384);
        constexpr int I_1 = 16 * 176, I_2 = 44 * 32, I_IN = 16 * 151, I_OA = 8 * 32, I_O = 16 * 32, I_PP = 4 * 32;
        constexpr int NITEMS = 2 * I_1 + 2 * I_2 + I_IN + 2 * I_OA + 2 * I_O + I_PP;
        for (int it = gw; it < NITEMS; it += NGW) {
            int r = it;
            if (r < I_1) { transpose_item<1>(args.in[4], D, 2 * DFF, W1a, args.in[3], scr, r, lane); continue; } r -= I_1;
            if (r < I_1) { transpose_item<1>(args.in[12], D, 2 * DFF, W1b, args.in[11], scr, r, lane); continue; } r -= I_1;
            if (r < I_2) { transpose_item<0>(args.in[5], DFF, D, W2a, nullptr, scr, r, lane); continue; } r -= I_2;
            if (r < I_2) { transpose_item<0>(args.in[13], DFF, D, W2b, nullptr, scr, r, lane); continue; } r -= I_2;
            if (r < I_IN) { transpose_item<2>(args.in[7], D, NIN, Win, args.in[6], scr, r, lane); continue; } r -= I_IN;
            if (r < I_OA) { transpose_item<0>(args.in[8], 512, D, WoA, nullptr, scr, r, lane, 1024, 0); continue; } r -= I_OA;
            if (r < I_OA) { transpose_item<0>(args.in[9], 512, D, WoA, nullptr, scr, r, lane, 1024, 512); continue; } r -= I_OA;
            if (r < I_O) { transpose_item<0>(args.in[10], D, D, Wout, nullptr, scr, r, lane); continue; } r -= I_O;
            if (r < I_O) { transpose_item<0>(args.in[15], D, D, Wpg, args.in[14], scr, r, lane, 1280, 256); continue; } r -= I_O;
            transpose_item<0>(args.in[16], PLE, D, Wpg, nullptr, scr, r, lane, 1280, 0);
        }
        for (int i = gt; i < 56 * D / 8; i += NGT) *(v4u*)(Win + (size_t)2760 * D + (size_t)i * 8) = (v4u){0u, 0u, 0u, 0u};
        for (int m = gw; m < T; m += NGW) {
            const f32x4* xr = (const f32x4*)(x + (size_t)m * D) + lane; unsigned long long* o8 = (unsigned long long*)(HB0 + (size_t)m * D) + lane; float s = 0.f;
#pragma unroll
            for (int j = 0; j < 4; ++j) { const f32x4 v = xr[64 * j]; s += (v[0] * v[0] + v[1] * v[1]) + (v[2] * v[2] + v[3] * v[3]); o8[64 * j] = (unsigned long long)pk2(v[0], v[1]) | ((unsigned long long)pk2(v[2], v[3]) << 32); }
            s = wave_sum(s);
            if (lane < 16) ssx[(size_t)m * 16 + lane] = lane == 0 ? s : 0.f;
        }
        for (int i = gt; i < T * 8; i += NGT) {
            const int c = i & 7; const float ang = (float)positions[i >> 3] * args.inv_freq[c];
            double rev = (double)ang * 0.15915494309189535; rev -= floor(rev); const float fr = (float)rev;
            rot[2 * i] = __builtin_amdgcn_cosf(fr); rot[2 * i + 1] = __builtin_amdgcn_sinf(fr);
        }
    }
    SEAM(0);
    if (IN(1)) { pg8::Gemm g{HB0, W1a, T, 2 * DFF, D}; pg8::StaticOrder S; S.init(T, 2 * DFF, G, bx); pg8::EpiSwiGLU E{BIG, DFF, pg8::build_rstd_tab((LAS float*)(lds + RTAB_OFF), ssx, S, wave)};
        pg8::gemm_phase<pg8::EpiSwiGLU, pg8::StaticOrder, true, true>(lds, g, S, E, wave); }
    SEAM(1);
    if (IN(2)) { pg8::Gemm g{BIG, W2a, T, D, DFF}; pg8::StaticOrder S; S.init(T, D, G, bx); pg8::EpiResid<false> E{HB0, HB1, ss1, 0.5f, 1024};
        pg8::gemm_phase<pg8::EpiResid<false>, pg8::StaticOrder, true, true>(lds, g, S, E, wave); }
    SEAM(2);
    if (IN(3)) { pg8::Gemm g{HB1, Win, T, NINV, D}; pg8::StaticOrder S; S.init(T, NINV, G, bx);
        pg8::EpiWin E{BIG, GATES, wi, pg8::build_rstd_tab((LAS float*)(lds + RTAB_OFF), ss1, S, wave), rot, 0.125f * 1.4426950408889634f, 0.125f * 0.35355339059327373f};
        pg8::gemm_phase<pg8::EpiWin, pg8::StaticOrder, true, true>(lds, g, S, E, wave); }
    SEAM(3);
    if (IN(4)) {
        if (wave >= 4) __builtin_amdgcn_s_setprio(1);
        { att::SbPre P; int k = 0; int pi = vcu; bool ok = pi < 512;
          if (ok) att::sb_prefetch(P, (pi >> 2) >> 3, (pi >> 2) & 7, 7 - (pi & 3), BIG, wave, mk_lane());
          while (ok) { const int bh = pi >> 2, s = pi & 3; const int qb = (k & 1) ? s : 7 - s;
              const int k2 = k + 1; const int pi2 = vcu + (k2 >> 1) * G; const bool ok2 = pi2 < 512; const int bh2 = pi2 >> 2, s2 = pi2 & 3; const int qb2 = (k2 & 1) ? s2 : 7 - s2;
              att::sb_unit(bh >> 3, bh & 7, qb, BIG, ysb, (LAS char*)lds, wave, P, ok2, bh2 >> 3, bh2 & 7, qb2);
              k = k2; pi = pi2; ok = ok2; } }
        { att::DsPre P; int k = 0; int pi = vcu; bool ok = pi < 512;
          if (ok) att::dsa_prefetch(P, pi >> 5, 63 - (pi & 31), BIG, wi, wave, mk_lane());
          while (ok) { const int b = pi >> 5, i = pi & 31; const int qblk = (k & 1) ? i : 63 - i;
              const int k2 = k + 1; const int pi2 = vcu + (k2 >> 1) * G; const bool ok2 = pi2 < 512; const int b2 = pi2 >> 5, i2 = pi2 & 31; const int qblk2 = (k2 & 1) ? i2 : 63 - i2;
              att::dsa_unit(b, qblk, BIG, wi, ydsa, (LAS char*)lds, wave, P, ok2, b2, qblk2);
              k = k2; pi = pi2; ok = ok2; } }
        __builtin_amdgcn_s_setprio(0);
    }
    SEAM(4);
    if (IN(5)) { pg8::Gemm g{ysb, WoA, T, D, D}; pg8::StaticOrder S; S.init(T, D, G, bx); pg8::EpiMerge E{GATES, mergedb};
        pg8::gemm_phase<pg8::EpiMerge, pg8::StaticOrder, true, true>(lds, g, S, E, wave); }
    SEAM(5);
    if (IN(6)) {
        for (int i = gt; i < T * PLE / 8; i += NGT) { const f32x4 a = *(const f32x4*)(pin + (size_t)i * 8), b = *(const f32x4*)(pin + (size_t)i * 8 + 4);
            *(v4u*)(AC + (size_t)(i >> 5) * 1280 + (i & 31) * 8) = (v4u){pk2(a[0], a[1]), pk2(a[2], a[3]), pk2(b[0], b[1]), pk2(b[2], b[3])}; }
        pg8::Gemm g{mergedb, Wout, T, D, D}; pg8::StaticOrder S; S.init(T, D, G, bx); pg8::EpiResid<false> E{HB1, HB1, ss2, 1.0f, 1024};
        pg8::gemm_phase<pg8::EpiResid<false>, pg8::StaticOrder, true, true>(lds, g, S, E, wave);
    }
    SEAM(6);
    if (IN(7)) { pg8::Gemm g{HB1, W1b, T, 2 * DFF, D}; pg8::StaticOrder S; S.init(T, 2 * DFF, G, bx); pg8::EpiSwiGLU E{BIG, DFF, pg8::build_rstd_tab((LAS float*)(lds + RTAB_OFF), ss2, S, wave)};
        pg8::gemm_phase<pg8::EpiSwiGLU, pg8::StaticOrder, true, true>(lds, g, S, E, wave); }
    SEAM(7);
    if (IN(8)) { pg8::Gemm g{BIG, W2b, T, D, DFF}; pg8::StaticOrder S; S.init(T, D, G, bx); pg8::EpiResid<false> E{HB1, AC + 256, ss3, 0.5f, 1280};
        pg8::gemm_phase<pg8::EpiResid<false>, pg8::StaticOrder, true, true>(lds, g, S, E, wave); }
    SEAM(8);
    if (IN(9)) { pg8::Gemm g{AC, Wpg, T, D, 1280}; pg8::StaticOrder S; S.init(T, D, G, bx);
        pg8::EpiPleM E{AC + 256, 1280, HB0, tmpb, ssx, pg8::build_rstd_tab((LAS float*)(lds + RTAB_OFF), ss3, S, wave)};
        pg8::gemm_phase<pg8::EpiPleM, pg8::StaticOrder, true, true>(lds, g, S, E, wave); }
    SEAM(9);
    if (IN(10)) {
        const f32x4* gr = (const f32x4*)args.in[17] + 2 * lane; f32x4 gv[4];
#pragma unroll
        for (int j = 0; j < 2; ++j) { gv[2 * j] = gr[128 * j]; gv[2 * j + 1] = gr[128 * j + 1]; }
        for (int m = gw; m < T; m += NGW) {
            const pg8::u32x4* hr = (const pg8::u32x4*)(HB0 + (size_t)m * D) + lane; f32x4* orow = (f32x4*)(out + (size_t)m * D) + 2 * lane;
            const float rs = pg8::row_rstd(ssx, m);
#pragma unroll
            for (int j = 0; j < 2; ++j) { const pg8::u32x4 w = hr[64 * j]; orow[128 * j] = pg8::bf_lo4(w) * rs * gv[2 * j]; orow[128 * j + 1] = pg8::bf_hi4(w) * rs * gv[2 * j + 1]; }
        }
    }
#undef IN
#undef tid
#undef lane
#undef SEAM
}

extern "C" void kernel_launch(void* const* d_in, const int* in_sizes, int n_in, void* d_out, int out_size, void* d_ws, size_t ws_size, hipStream_t stream) {
    static int grid = 0;
    if (grid == 0) {
        if (n_in != 18 || out_size != T * D || ws_size < WS_END) { fprintf(stderr, "kernel_launch: unexpected problem (n_in %d, out %d, ws %zu)\n", n_in, out_size, ws_size); grid = -1; return; }
        int dev = 0, cus = 0, per_cu = 0;
        hipGetDevice(&dev); hipDeviceGetAttribute(&cus, hipDeviceAttributeMultiprocessorCount, dev);
        hipFuncSetAttribute((const void*)mk_fwd, hipFuncAttributeMaxDynamicSharedMemorySize, LDS_BYTES);
        hipOccupancyMaxActiveBlocksPerMultiprocessor(&per_cu, (const void*)mk_fwd, NWAVES * 64, LDS_BYTES);
        (void)hipGetLastError();
        if (per_cu < 1) per_cu = 1;
        if (cus != 256) { fprintf(stderr, "kernel_launch: built for a 256-CU device (got %d)\n", cus); grid = -1; return; }
        grid = cus * 1;
        fprintf(stderr, "kernel_launch: grid %d (occupancy query %d per CU), ws %zu\n", grid, per_cu, ws_size);
    }
    if (grid < 0) return;
    if (hipMemsetAsync((char*)d_ws + WS_CTL, 0, CTL_BYTES, stream) != hipSuccess) { fprintf(stderr, "kernel_launch: memset failed\n"); return; }
    Args a{};
    for (int i = 0; i < 18; ++i) a.in[i] = (const float*)d_in[i];
    a.out = (float*)d_out; a.ws = (unsigned char*)d_ws;
    for (int c = 0; c < 8; ++c) a.inv_freq[c] = (float)pow(500000.0, -(double)(2 * c) / 16.0);
#if MK_N_LAUNCHES == 1
    a.ph_lo = 0; a.ph_hi = NPHASE;
    void* kargs[] = {&a};
    hipError_t e = hipLaunchCooperativeKernel((const void*)mk_fwd, dim3(grid), dim3(NWAVES * 64), kargs, LDS_BYTES, stream);
    if (e != hipSuccess) fprintf(stderr, "kernel_launch: cooperative launch failed: %s\n", hipGetErrorString(e));
#else
    for (int ph = 0; ph < NPHASE; ++ph) { a.ph_lo = ph; a.ph_hi = ph + 1;
        hipLaunchKernelGGL(mk_fwd, dim3(grid), dim3(NWAVES * 64), LDS_BYTES, stream, a);
#ifdef PROBE_PH
        if (ph == PROBE_PH) hipLaunchKernelGGL(mk_fwd, dim3(grid), dim3(NWAVES * 64), LDS_BYTES, stream, a);
#endif
    }
#endif
}
```

```cpp
#include <hip/hip_runtime.h>
#include <hip/hip_cooperative_groups.h>
#include <hip/hip_bf16.h>
#include <cstdio>
#include <cstdint>
#include <cmath>
namespace cg = cooperative_groups;
__device__ __forceinline__ int mk_lane() { int l; asm volatile("v_mbcnt_lo_u32_b32 %0, -1, 0\n\tv_mbcnt_hi_u32_b32 %0, -1, %0" : "=v"(l)); return l; }
#define MK_N_LAUNCHES 1
namespace pg8 {
#define PG8_LAS __attribute__((address_space(3)))
typedef unsigned short bf16_t;
typedef short bf16x8 __attribute__((ext_vector_type(8)));
typedef float f32x4 __attribute__((ext_vector_type(4)));
typedef unsigned u32x4 __attribute__((ext_vector_type(4)));
constexpr int BM = 256, BK = 64, HALF = 128, HTB = HALF * BK * 2  , STAGE_BYTES = 8 * HTB, NXCD = 8, WGM = 8;

__host__ __device__ __forceinline__ int lds_byte(int r, int c) { const int st = (r >> 4) * 2 + (c >> 5), rr = r & 15, cc = c & 31, ob = rr * 64 + cc * 2; return st * 1024 + (ob ^ (((ob >> 9) & 1) << 5)); }
__host__ __device__ __forceinline__ void stage_rc(int b, int& R, int& C) { const int st = b / 1024, sb = b % 1024, swz = sb ^ (((sb >> 9) & 1) << 5); R = (st >> 1) * 16 + swz / 64; C = (st & 1) * 32 + (swz % 64) / 2; }
__host__ __device__ __forceinline__ int perm32(int rho) { const int n = rho >> 4, i = rho & 15; return 8 * (i >> 2) + 4 * n + (i & 3); }

struct Unit { int pm, pn; };
struct Gemm { const bf16_t* A; const bf16_t* Bt; int M, N, K; };

struct StaticOrder {
    int nM, nN, nwg, G, c;
    __host__ __device__ void init(int M, int N, int G_, int c_) { nM = M / BM; nN = N / BM; nwg = nM * nN; G = G_; c = c_; }
    __host__ __device__ bool next(int i, Unit& u) const {
        const long L = (long)i * G + c; if (L >= nwg) return false;
        int wgid = (int)L; { const int q = nwg / NXCD, r = nwg % NXCD, xcd = wgid % NXCD, off = wgid / NXCD; wgid = (xcd < r ? xcd * (q + 1) : r * (q + 1) + (xcd - r) * q) + off; }
        const int nig = WGM * nN, gid = wgid / nig, fm = gid * WGM, gsz = (nM - fm) < WGM ? (nM - fm) : WGM;
        u.pm = fm + ((wgid % nig) % gsz); u.pn = (wgid % nig) / gsz; return true;
    }
    __device__ __forceinline__ void a_ready(const Unit&) const {}
    __device__ __forceinline__ void done(const Unit&) const {}
};

typedef float f32x2_cv __attribute__((ext_vector_type(2))); typedef __bf16 bf16x2_cv __attribute__((ext_vector_type(2)));
__device__ __forceinline__ unsigned cvt_pk_bf16(float lo, float hi) { f32x2_cv v = {lo, hi}; bf16x2_cv b = __builtin_convertvector(v, bf16x2_cv); return __builtin_bit_cast(unsigned, b); }
typedef float f32x2 __attribute__((ext_vector_type(2)));
typedef unsigned u32x2 __attribute__((ext_vector_type(2)));
__device__ __forceinline__ float bf2f(unsigned short b) { return __uint_as_float(((unsigned)b) << 16); }
__device__ __forceinline__ float row_rstd(const float* ss, int row) {
    const f32x4* p = (const f32x4*)(ss + (size_t)row * 16);
    const f32x4 a = p[0], b = p[1], c = p[2], d = p[3];
    const float s = (((a[0] + a[1]) + (a[2] + a[3])) + ((b[0] + b[1]) + (b[2] + b[3]))) + (((c[0] + c[1]) + (c[2] + c[3])) + ((d[0] + d[1]) + (d[2] + d[3])));
    return __builtin_amdgcn_rsqf(s * (1.0f / 1024.0f) + 1e-6f);
}
struct RstdTab { const PG8_LAS float* tab; int pmA; };
template <class Sched> __device__ __forceinline__ RstdTab build_rstd_tab(PG8_LAS float* tab, const float* ss, const Sched& S, int wid) {
    Unit u; int pmA = -1, pmB = -1;
    for (int i = 0; S.next(i, u); ++i) { if (pmA < 0) pmA = u.pm; else if (u.pm != pmA) pmB = u.pm; }
    const int t = wid * 64 + mk_lane(); const int pm = t < 256 ? pmA : pmB;
    if (pm >= 0) tab[t] = row_rstd(ss, pm * BM + (t & 255));
    __syncthreads();
    return RstdTab{tab, pmA};
}
__device__ __forceinline__ float sigmoid_f(float v) { return __builtin_amdgcn_rcpf(1.0f + __builtin_amdgcn_exp2f(-1.4426950408889634f * v)); }
__device__ __forceinline__ float silu_f(float v) { return v * sigmoid_f(v); }

typedef unsigned u32x4 __attribute__((ext_vector_type(4)));
__device__ __forceinline__ f32x4 bf_lo4(u32x4 w) { f32x4 r; r[0] = __uint_as_float(w.x << 16); r[1] = __uint_as_float(w.x & 0xffff0000u); r[2] = __uint_as_float(w.y << 16); r[3] = __uint_as_float(w.y & 0xffff0000u); return r; }
__device__ __forceinline__ f32x4 bf_hi4(u32x4 w) { f32x4 r; r[0] = __uint_as_float(w.z << 16); r[1] = __uint_as_float(w.z & 0xffff0000u); r[2] = __uint_as_float(w.w << 16); r[3] = __uint_as_float(w.w & 0xffff0000u); return r; }
__device__ __forceinline__ u32x4 pack8(f32x4 a, f32x4 b) { u32x4 w; w.x = cvt_pk_bf16(a[0], a[1]); w.y = cvt_pk_bf16(a[2], a[3]); w.z = cvt_pk_bf16(b[0], b[1]); w.w = cvt_pk_bf16(b[2], b[3]); return w; }

#ifndef PROBE_SWIGLU
#define PROBE_SWIGLU false
#endif
#ifndef PROBE_WIN
#define PROBE_WIN false
#endif
struct EpiSwiGLU {
    static constexpr bool PERM = true, AFTER_DRAIN = false, IDEMPOTENT = PROBE_SWIGLU; static constexpr int MID_T = -1;
    bf16_t* O; int ldo; RstdTab rt;
    __device__ __forceinline__ void operator()(const f32x4 (&acc)[2][2][4][2], const Unit& u, int wr, int wc, int fr, int fq) const {
        const int row0 = u.pm * BM + wr * 64 + fr; const int col0 = u.pn * HALF + wc * 32 + 8 * fq;
        const PG8_LAS float* rtab = rt.tab + (u.pm == rt.pmA ? 0 : 256) + wr * 64 + fr;
#pragma unroll
        for (int ai = 0; ai < 2; ++ai)
#pragma unroll
            for (int m = 0; m < 4; ++m) { if (m == 0) asm volatile("" ::: "memory");
                const int row = row0 + ai * HALF + m * 16; const float rs = rtab[ai * HALF + m * 16];
                const f32x4 a0 = acc[ai][0][m][0] * rs, a1 = acc[ai][0][m][1] * rs, b0 = acc[ai][1][m][0] * rs, b1 = acc[ai][1][m][1] * rs;
                f32x4 o0, o1;
#pragma unroll
                for (int e = 0; e < 4; ++e) { o0[e] = silu_f(a0[e]) * b0[e]; o1[e] = silu_f(a1[e]) * b1[e]; }
                *(u32x4*)(O + (size_t)row * ldo + col0) = pack8(o0, o1);
            }
    }
};

template <bool BASE_F32> struct EpiResid {
    static constexpr bool PERM = true, AFTER_DRAIN = false, IDEMPOTENT = false; static constexpr int MID_T = -1;
    const void* base; bf16_t* outb; float* ss_out; float scale; int ldo;
    __device__ __forceinline__ void operator()(const f32x4 (&acc)[2][2][4][2], const Unit& u, int wr, int wc, int fr, int fq) const {
        const int row0 = u.pm * BM + wr * 64 + fr; const int col0 = u.pn * BM + wc * 32 + 8 * fq;
#pragma unroll
        for (int ai = 0; ai < 2; ++ai)
#pragma unroll
            for (int m = 0; m < 4; ++m) { if (m == 0) asm volatile("" ::: "memory");
                const int row = row0 + ai * HALF + m * 16; const size_t off = (size_t)row * 1024 + col0; float q = 0.f;
#pragma unroll
                for (int bj = 0; bj < 2; ++bj) {
                    f32x4 b0, b1;
                    if (BASE_F32) { b0 = *(const f32x4*)((const float*)base + off + bj * HALF); b1 = *(const f32x4*)((const float*)base + off + bj * HALF + 4); }
                    else { const u32x4 bw = *(const u32x4*)((const bf16_t*)base + off + bj * HALF); b0 = bf_lo4(bw); b1 = bf_hi4(bw); }
                    const f32x4 o0 = b0 + acc[ai][bj][m][0] * scale, o1 = b1 + acc[ai][bj][m][1] * scale;
                    q += ((o0[0] * o0[0] + o0[1] * o0[1]) + (o0[2] * o0[2] + o0[3] * o0[3])) + ((o1[0] * o1[0] + o1[1] * o1[1]) + (o1[2] * o1[2] + o1[3] * o1[3]));
                    *(u32x4*)(outb + (size_t)row * ldo + col0 + bj * HALF) = pack8(o0, o1);
                }
                q += __shfl_xor(q, 16); q += __shfl_xor(q, 32);
                if (fq == 0) ss_out[(size_t)row * 16 + u.pn * 4 + wc] = q;
            }
    }
};

struct EpiWin {
    static constexpr bool PERM = true, AFTER_DRAIN = false, IDEMPOTENT = PROBE_WIN; static constexpr int MID_T = -1;
    bf16_t* qkv; bf16_t* gates; float* wi; RstdTab rt; const float* rot; float c2, wscale;
    __device__ __forceinline__ void operator()(const f32x4 (&acc)[2][2][4][2], const Unit& u, int wr, int wc, int fr, int fq) const {
        const int row0 = u.pm * BM + wr * 64 + fr; const int pn = u.pn;
        const bool rot_tile = (pn >= 6 && pn <= 10);
        const float qs = (pn <= 1 || pn == 6 || pn == 7) ? c2 : 1.0f;
        const PG8_LAS float* rtab = rt.tab + (u.pm == rt.pmA ? 0 : 256) + wr * 64 + fr;
#pragma unroll
        for (int ai = 0; ai < 2; ++ai)
#pragma unroll
            for (int m = 0; m < 4; ++m) { if (m == 0) asm volatile("" ::: "memory");
                const int row = row0 + ai * HALF + m * 16; const float rs = rtab[ai * HALF + m * 16];
#pragma unroll
                for (int bj = 0; bj < 2; ++bj) {
                    f32x4 v0 = acc[ai][bj][m][0] * rs, v1 = acc[ai][bj][m][1] * rs;
                    const int vcol = 128 * bj + 32 * wc + 8 * fq;
                    if (pn <= 10) {
                        const int g = 2 * bj + (wc >> 1);
                        if (rot_tile && (wc & 1) == 0 && (pn != 10 || g == 0 || g == 2)) {
                            if (fq < 2) { const f32x4 c0 = *(const f32x4*)(rot + (size_t)row * 16 + 8 * fq), c1 = *(const f32x4*)(rot + (size_t)row * 16 + 8 * fq + 4);
                                const f32x4 x = v0, y = v1;
                                v0[0] = x[0] * c0[0] - x[1] * c0[1]; v0[1] = x[1] * c0[0] + x[0] * c0[1]; v0[2] = x[2] * c0[2] - x[3] * c0[3]; v0[3] = x[3] * c0[2] + x[2] * c0[3];
                                v1[0] = y[0] * c1[0] - y[1] * c1[1]; v1[1] = y[1] * c1[0] + y[0] * c1[1]; v1[2] = y[2] * c1[2] - y[3] * c1[3]; v1[3] = y[3] * c1[2] + y[2] * c1[3]; }
                        }
                        if (pn == 10 && g == 3) {
                            if (wc == 2 && fq == 0) { *(f32x4*)(wi + (size_t)row * 8) = v0 * wscale; *(f32x4*)(wi + (size_t)row * 8 + 4) = v1 * wscale; }
                        } else *(u32x4*)(qkv + (size_t)row * 2816 + pn * 256 + vcol) = pack8(v0 * qs, v1 * qs);
                    } else {
                        f32x4 s0, s1;
#pragma unroll
                        for (int e = 0; e < 4; ++e) { s0[e] = sigmoid_f(v0[e]); s1[e] = sigmoid_f(v1[e]); }
                        *(u32x4*)(gates + (size_t)row * 2048 + (pn - 11) * 256 + vcol) = pack8(s0, s1);
                    }
                }
            }
    }
};

struct EpiMerge {
    static constexpr bool PERM = true, AFTER_DRAIN = false, IDEMPOTENT = false; static constexpr int MID_T = 8;
    const bf16_t* gate; bf16_t* out;
    __device__ __forceinline__ void mid(f32x4 (&acc)[2][2][4][2], const Unit& u, int wr, int wc, int fr, int fq) const {
        const int row0 = u.pm * BM + wr * 64 + fr; const int col0 = u.pn * BM + wc * 32 + 8 * fq;
#pragma unroll
        for (int ai = 0; ai < 2; ++ai)
#pragma unroll
            for (int m = 0; m < 4; ++m) {
                const bf16_t* gp = gate + (size_t)(row0 + ai * HALF + m * 16) * 2048 + col0;
#pragma unroll
                for (int bj = 0; bj < 2; ++bj) { asm volatile("" ::: "memory");
                    const u32x4 ga = *(const u32x4*)(gp + bj * HALF), gb = *(const u32x4*)(gp + 1024 + bj * HALF);
                    const f32x4 a0 = bf_lo4(ga), a1 = bf_hi4(ga), b0 = bf_lo4(gb), b1 = bf_hi4(gb);
#pragma unroll
                    for (int e = 0; e < 4; ++e) { acc[ai][bj][m][0][e] *= a0[e] * __builtin_amdgcn_rcpf(fmaxf(b0[e], 1e-30f)); acc[ai][bj][m][1][e] *= a1[e] * __builtin_amdgcn_rcpf(fmaxf(b1[e], 1e-30f)); }
                }
            }
    }
    __device__ __forceinline__ void operator()(const f32x4 (&acc)[2][2][4][2], const Unit& u, int wr, int wc, int fr, int fq) const {
        const int row0 = u.pm * BM + wr * 64 + fr; const int col0 = u.pn * BM + wc * 32 + 8 * fq;
#pragma unroll
        for (int ai = 0; ai < 2; ++ai)
#pragma unroll
            for (int m = 0; m < 4; ++m) { if (m == 0) asm volatile("" ::: "memory");
                const int row = row0 + ai * HALF + m * 16;
#pragma unroll
                for (int bj = 0; bj < 2; ++bj) {
                    const u32x4 gb = *(const u32x4*)(gate + (size_t)row * 2048 + 1024 + col0 + bj * HALF);
                    f32x4 b0 = bf_lo4(gb), b1 = bf_hi4(gb);
#pragma unroll
                    for (int e = 0; e < 4; ++e) { b0[e] = fmaxf(b0[e], 1e-30f); b1[e] = fmaxf(b1[e], 1e-30f); }
                    *(u32x4*)(out + (size_t)row * 1024 + col0 + bj * HALF) = pack8(acc[ai][bj][m][0] * b0, acc[ai][bj][m][1] * b1);
                }
            }
    }
};

struct EpiPleM {
    static constexpr bool PERM = true, AFTER_DRAIN = false, IDEMPOTENT = false; static constexpr int MID_T = 4;
    const bf16_t* base; int ldb; bf16_t* outb; bf16_t* tmp; float* ss_out; RstdTab rt;
    __device__ __forceinline__ void mid(f32x4 (&acc)[2][2][4][2], const Unit& u, int wr, int wc, int fr, int fq) const {
        const int row0 = u.pm * BM + wr * 64 + fr; const int col0 = u.pn * BM + wc * 32 + 8 * fq;
#pragma unroll
        for (int ai = 0; ai < 2; ++ai)
#pragma unroll
            for (int m = 0; m < 4; ++m)
#pragma unroll
                for (int bj = 0; bj < 2; ++bj) {
                    *(u32x4*)(tmp + (size_t)(row0 + ai * HALF + m * 16) * 1024 + col0 + bj * HALF) = pack8(acc[ai][bj][m][0], acc[ai][bj][m][1]);
                    acc[ai][bj][m][0] = (f32x4){0.f, 0.f, 0.f, 0.f}; acc[ai][bj][m][1] = (f32x4){0.f, 0.f, 0.f, 0.f};
                }
    }
    __device__ __forceinline__ void operator()(const f32x4 (&acc)[2][2][4][2], const Unit& u, int wr, int wc, int fr, int fq) const {
        const int row0 = u.pm * BM + wr * 64 + fr; const int col0 = u.pn * BM + wc * 32 + 8 * fq;
        const PG8_LAS float* rtab = rt.tab + (u.pm == rt.pmA ? 0 : 256) + wr * 64 + fr;
        __builtin_amdgcn_fence(__ATOMIC_ACQUIRE, "agent");
#pragma unroll
        for (int ai = 0; ai < 2; ++ai)
#pragma unroll
            for (int m = 0; m < 4; ++m) { if (m == 0) asm volatile("" ::: "memory");
                const int row = row0 + ai * HALF + m * 16; const float rs = rtab[ai * HALF + m * 16]; float q = 0.f;
#pragma unroll
                for (int bj = 0; bj < 2; ++bj) {
                    const u32x4 tw = *(const u32x4*)(tmp + (size_t)row * 1024 + col0 + bj * HALF), bw = *(const u32x4*)(base + (size_t)row * ldb + col0 + bj * HALF);
                    const f32x4 a0 = acc[ai][bj][m][0] * rs, a1 = acc[ai][bj][m][1] * rs; f32x4 o0 = bf_lo4(bw), o1 = bf_hi4(bw); const f32x4 t0 = bf_lo4(tw), t1 = bf_hi4(tw);
#pragma unroll
                    for (int e = 0; e < 4; ++e) { o0[e] += sigmoid_f(a0[e]) * t0[e]; o1[e] += sigmoid_f(a1[e]) * t1[e]; }
                    q += ((o0[0] * o0[0] + o0[1] * o0[1]) + (o0[2] * o0[2] + o0[3] * o0[3])) + ((o1[0] * o1[0] + o1[1] * o1[1]) + (o1[2] * o1[2] + o1[3] * o1[3]));
                    *(u32x4*)(outb + (size_t)row * 1024 + col0 + bj * HALF) = pack8(o0, o1);
                }
                q += __shfl_xor(q, 16); q += __shfl_xor(q, 32);
                if (fq == 0) ss_out[(size_t)row * 16 + u.pn * 4 + wc] = q;
            }
    }
};
template <class Epi, class Sched, bool ALIGN_EPI = false, bool SP2 = false>
__device__ __forceinline__ void gemm_phase(PG8_LAS unsigned char* lds, const Gemm g, const Sched& S, const Epi& E, const int wid) {
    const int lane = mk_lane(), tid = wid * 64 + lane, wr = wid >> 2, wc = wid & 3, fr = lane & 15, fq = lane >> 4;
    int K_ = g.K; asm volatile("" : "+s"(K_)); const int K = K_, nt = K / BK;
    unsigned voffA[2], voffB[2];
#pragma unroll
    for (int i = 0; i < 2; ++i) { int R, C; stage_rc(tid * 16 + i * 8192, R, C); const int Rb = Epi::PERM ? ((R & ~31) + perm32(R & 31)) : R;
        voffA[i] = (unsigned)(R * K + C) * 2u; voffB[i] = (unsigned)(Rb * K + C) * 2u; }
    const size_t kstep = (size_t)(BK * 2);
    const size_t hstep = (size_t)HALF * K * 2;
    const size_t tstep = 2 * hstep;
    const unsigned ldsw = (unsigned)wid * 1024u;
    const int aoff = lds_byte(wr * 64 + fr, fq * 8), boff = lds_byte(wc * 32 + fr, fq * 8);
#define PG8_SA(b, h) (((b) * 2 + (h)) * HTB)
#define PG8_SB(b, h) ((4 + (b) * 2 + (h)) * HTB)
#define PG8_STAGE(bufoff, gbase, voff) do { _Pragma("unroll") for (int _i = 0; _i < 2; ++_i) \
        __builtin_amdgcn_global_load_lds((const unsigned*)((const char*)(gbase) + (voff)[_i]), (PG8_LAS unsigned*)(lds + (bufoff) + ldsw + _i * 8192), 16, 0, 0); } while (0)
#define PG8_LDA(dst, b, h) do { _Pragma("unroll") for (int m = 0; m < 4; ++m) _Pragma("unroll") for (int k = 0; k < 2; ++k) dst[m][k] = *(const PG8_LAS bf16x8*)(lds + PG8_SA(b, h) + aoff + m * 2048 + k * 1024); } while (0)
#define PG8_LDB(dst, b, h) do { _Pragma("unroll") for (int n = 0; n < 2; ++n) _Pragma("unroll") for (int k = 0; k < 2; ++k) dst[n][k] = *(const PG8_LAS bf16x8*)(lds + PG8_SB(b, h) + boff + n * 2048 + k * 1024); } while (0)
#define PG8_MMA(ai, bj, At, Bt) do { __builtin_amdgcn_s_setprio(1); _Pragma("unroll") for (int m = 0; m < 4; ++m) _Pragma("unroll") for (int n = 0; n < 2; ++n) _Pragma("unroll") for (int k = 0; k < 2; ++k) \
        acc[ai][bj][m][n] = __builtin_amdgcn_mfma_f32_16x16x32_bf16(Bt[n][k], At[m][k], acc[ai][bj][m][n], 0, 0, 0); __builtin_amdgcn_s_setprio(0); } while (0)
#define PG8_WAIT_V(n) asm volatile("s_waitcnt vmcnt(" #n ")" ::: "memory")
#define PG8_WAIT_L(n) asm volatile("s_waitcnt lgkmcnt(" #n ")" ::: "memory")
#define PG8_BAR __builtin_amdgcn_s_barrier()
#define PG8_SCHED __builtin_amdgcn_sched_barrier(0)
    Unit cur, nxt; int ui = 0;
    if (!S.next(0, cur)) return;
    f32x4 acc[2][2][4][2];
#pragma unroll
    for (int a = 0; a < 2; ++a)
#pragma unroll
        for (int b = 0; b < 2; ++b)
#pragma unroll
            for (int m = 0; m < 4; ++m)
#pragma unroll
                for (int n = 0; n < 2; ++n) acc[a][b][m][n] = (f32x4){0.f, 0.f, 0.f, 0.f};
    bf16x8 At[4][2], B0[2][2], B1[2][2];
    const char* cA = (const char*)g.A + (size_t)cur.pm * tstep; const char* cB = (const char*)g.Bt + (size_t)cur.pn * tstep;
    S.a_ready(cur);
    if constexpr (SP2) {
        PG8_STAGE(PG8_SB(0, 0), cB, voffB); PG8_STAGE(PG8_SB(0, 1), cB + hstep, voffB); PG8_STAGE(PG8_SA(0, 0), cA, voffA); PG8_STAGE(PG8_SA(0, 1), cA + hstep, voffA);
        if (wr == 1) PG8_BAR;
        PG8_WAIT_V(2); PG8_BAR;
        PG8_STAGE(PG8_SB(1, 0), cB + kstep, voffB); PG8_STAGE(PG8_SA(1, 0), cA + kstep, voffA); PG8_STAGE(PG8_SB(1, 1), cB + hstep + kstep, voffB);
        PG8_WAIT_V(6); PG8_BAR;
    } else {
        PG8_STAGE(PG8_SB(0, 0), cB, voffB); PG8_STAGE(PG8_SA(0, 0), cA, voffA); PG8_STAGE(PG8_SB(0, 1), cB + hstep, voffB); PG8_STAGE(PG8_SA(0, 1), cA + hstep, voffA);
        if (wr == 1) PG8_BAR;
        PG8_WAIT_V(4); PG8_BAR;
        PG8_STAGE(PG8_SB(1, 0), cB + kstep, voffB); PG8_STAGE(PG8_SA(1, 0), cA + kstep, voffA); PG8_STAGE(PG8_SB(1, 1), cB + hstep + kstep, voffB);
        PG8_WAIT_V(6); PG8_BAR;
    }
    for (;;) {
        const bool has_next = S.next(ui + 1, nxt);
        const char* nA = has_next ? (const char*)g.A + (size_t)nxt.pm * tstep : cA; const char* nB = has_next ? (const char*)g.Bt + (size_t)nxt.pn * tstep : cB;
        for (int t = 0; t < nt; t += 2) {
            if constexpr (Epi::MID_T >= 0) { if (t == Epi::MID_T) E.mid(acc, cur, wr, wc, fr, fq); }
            const bool last = (t == nt - 2);
            const char* a1 = cA + (size_t)(t + 1) * kstep;
            const char* a2 = last ? nA : cA + (size_t)(t + 2) * kstep; const char* b2 = last ? nB : cB + (size_t)(t + 2) * kstep;
            const char* a3 = a2 + kstep; const char* b3 = b2 + kstep;
            if (last && has_next) S.a_ready(nxt);
            if constexpr (SP2) {
            PG8_LDB(B0, 0, 0); PG8_LDB(B1, 0, 1); PG8_SCHED; PG8_LDA(At, 0, 0); PG8_STAGE(PG8_SA(1, 1), a1 + hstep, voffA);
            PG8_WAIT_V(8); PG8_WAIT_L(0); PG8_BAR; PG8_MMA(0, 0, At, B0); PG8_MMA(0, 1, At, B1); PG8_BAR; PG8_SCHED;
            PG8_LDA(At, 0, 1); PG8_STAGE(PG8_SB(0, 0), b2, voffB); PG8_STAGE(PG8_SB(0, 1), b2 + hstep, voffB); PG8_STAGE(PG8_SA(0, 0), a2, voffA);
            PG8_WAIT_V(8); PG8_WAIT_L(0); PG8_BAR; PG8_MMA(1, 0, At, B0); PG8_MMA(1, 1, At, B1); PG8_BAR; PG8_SCHED;
            PG8_LDB(B0, 1, 0); PG8_LDB(B1, 1, 1); PG8_SCHED; PG8_LDA(At, 1, 0); PG8_STAGE(PG8_SA(0, 1), a2 + hstep, voffA);
            PG8_WAIT_V(8); PG8_WAIT_L(0); PG8_BAR; PG8_MMA(0, 0, At, B0); PG8_MMA(0, 1, At, B1); PG8_BAR; PG8_SCHED;
            PG8_LDA(At, 1, 1); PG8_STAGE(PG8_SB(1, 0), b3, voffB); PG8_STAGE(PG8_SB(1, 1), b3 + hstep, voffB); PG8_STAGE(PG8_SA(1, 0), a3, voffA);
            PG8_WAIT_V(8); PG8_WAIT_L(0); PG8_BAR; PG8_MMA(1, 0, At, B0); PG8_MMA(1, 1, At, B1); PG8_BAR; PG8_SCHED;
            } else {
            PG8_LDB(B0, 0, 0); PG8_SCHED; PG8_LDA(At, 0, 0); PG8_STAGE(PG8_SA(1, 1), a1 + hstep, voffA);
            PG8_WAIT_L(8); PG8_BAR; PG8_WAIT_L(0); PG8_MMA(0, 0, At, B0); PG8_BAR; PG8_SCHED;
            PG8_LDB(B1, 0, 1); PG8_STAGE(PG8_SB(0, 0), b2, voffB);
            PG8_BAR; PG8_WAIT_L(0); PG8_MMA(0, 1, At, B1); PG8_BAR;
            PG8_LDA(At, 0, 1); PG8_STAGE(PG8_SA(0, 0), a2, voffA);
            PG8_BAR; PG8_WAIT_L(0); PG8_MMA(1, 0, At, B0); PG8_BAR; PG8_SCHED;
            PG8_STAGE(PG8_SB(0, 1), b2 + hstep, voffB);
            PG8_WAIT_V(6); PG8_BAR; PG8_MMA(1, 1, At, B1); PG8_BAR;
            PG8_LDB(B0, 1, 0); PG8_SCHED; PG8_LDA(At, 1, 0); PG8_STAGE(PG8_SA(0, 1), a2 + hstep, voffA);
            PG8_WAIT_L(8); PG8_BAR; PG8_WAIT_L(0); PG8_MMA(0, 0, At, B0); PG8_BAR; PG8_SCHED;
            PG8_LDB(B1, 1, 1); PG8_STAGE(PG8_SB(1, 0), b3, voffB);
            PG8_BAR; PG8_WAIT_L(0); PG8_MMA(0, 1, At, B1); PG8_BAR;
            PG8_LDA(At, 1, 1); PG8_STAGE(PG8_SA(1, 0), a3, voffA);
            PG8_BAR; PG8_WAIT_L(0); PG8_MMA(1, 0, At, B0); PG8_BAR; PG8_SCHED;
            PG8_STAGE(PG8_SB(1, 1), b3 + hstep, voffB);
            PG8_WAIT_V(6); PG8_BAR; PG8_MMA(1, 1, At, B1); PG8_BAR;
            }
        }
        if constexpr (ALIGN_EPI) { if (wr == 0) PG8_BAR; }
        if constexpr (!Epi::AFTER_DRAIN) { E(acc, cur, wr, wc, fr, fq);
#ifdef PROBE_EPI2
            if constexpr (Epi::IDEMPOTENT) { asm volatile("" ::: "memory"); E(acc, cur, wr, wc, fr, fq); }
#endif
            S.done(cur); }
        if (!has_next) break;
#pragma unroll
        for (int a = 0; a < 2; ++a)
#pragma unroll
            for (int b = 0; b < 2; ++b)
#pragma unroll
                for (int m = 0; m < 4; ++m)
#pragma unroll
                    for (int n = 0; n < 2; ++n) acc[a][b][m][n] = (f32x4){0.f, 0.f, 0.f, 0.f};
        cur = nxt; cA = nA; cB = nB; ++ui;
        if constexpr (ALIGN_EPI) { if (wr == 1) PG8_BAR; }
    }
    PG8_WAIT_V(0);
    if constexpr (!ALIGN_EPI) { if (wr == 0) PG8_BAR; }
    PG8_BAR;
    if constexpr (Epi::AFTER_DRAIN) { E.fused(acc, cur, wr, wc, fr, fq, lds, wid, lane); S.done(cur); }
#undef PG8_SA
#undef PG8_SB
#undef PG8_STAGE
#undef PG8_LDA
#undef PG8_LDB
#undef PG8_MMA
#undef PG8_WAIT_V
#undef PG8_WAIT_L
#undef PG8_BAR
#undef PG8_SCHED
}
}
namespace att {
typedef short bf16x8 __attribute__((ext_vector_type(8)));
typedef short s16x4 __attribute__((ext_vector_type(4)));
typedef float f32x16 __attribute__((ext_vector_type(16)));
typedef float f32x4 __attribute__((ext_vector_type(4)));
typedef unsigned u32x4 __attribute__((ext_vector_type(4)));
typedef unsigned short bf16_t;
#define ALAS __attribute__((address_space(3)))
constexpr int SEQ = 2048, LDQ = 2816;
constexpr int SLOTB = 8192;
constexpr int L_K = 0, L_V = 2 * SLOTB, L_WS = 4 * SLOTB, L_OST = L_WS + 8 * 256, L_END = L_OST + 8 * 4096;
constexpr int L_SC = 0, L_MASK = 131072, L_WL = 131072 + 8192;

__device__ __forceinline__ int crow(int r, int hi) { return (r & 3) + 8 * (r >> 2) + 4 * hi; }
__device__ __forceinline__ unsigned cvtpk(float lo, float hi) { return pg8::cvt_pk_bf16(lo, hi); }
__device__ __forceinline__ float other_half(float mine) {
    const unsigned mb = __float_as_uint(mine);
    auto rr = __builtin_amdgcn_permlane32_swap(mb, mb, false, false);
    return __uint_as_float(rr[0] == mb ? rr[1] : rr[0]);
}
__device__ __forceinline__ float both_sum(float mine) { const unsigned mb = __float_as_uint(mine); auto rr = __builtin_amdgcn_permlane32_swap(mb, mb, false, false); return __uint_as_float(rr[0]) + __uint_as_float(rr[1]); }
__device__ __forceinline__ float both_max(float mine) { const unsigned mb = __float_as_uint(mine); auto rr = __builtin_amdgcn_permlane32_swap(mb, mb, false, false); return fmaxf(__uint_as_float(rr[0]), __uint_as_float(rr[1])); }
__device__ __forceinline__ void both_vals(float mine, float& lo, float& up) { const unsigned mb = __float_as_uint(mine); auto rr = __builtin_amdgcn_permlane32_swap(mb, mb, false, false); lo = __uint_as_float(rr[0]); up = __uint_as_float(rr[1]); }
__device__ __forceinline__ void qkt(f32x16& p0, f32x16& p1, const ALAS char* Kslot, const bf16x8* qr, int r32, int hi) {
    const ALAS char* kb = Kslot + hi * 1024 + r32 * 16;
    p0 = f32x16{}; p1 = f32x16{};
#pragma unroll
    for (int d0 = 0; d0 < 4; ++d0) {
        const bf16x8 b0 = *(const ALAS bf16x8*)(kb + d0 * 2048);
        const bf16x8 b1 = *(const ALAS bf16x8*)(kb + d0 * 2048 + 512);
        p0 = __builtin_amdgcn_mfma_f32_32x32x16_bf16(b0, qr[d0], p0, 0, 0, 0);
        p1 = __builtin_amdgcn_mfma_f32_32x32x16_bf16(b1, qr[d0], p1, 0, 0, 0);
    }
}
__device__ __forceinline__ void qkt_c(f32x16& p0, f32x16& p1, const ALAS char* Kslot, const bf16x8* qr, const f32x16& c0, int r32, int hi) {
    const ALAS char* kb = Kslot + hi * 1024 + r32 * 16;
#pragma unroll
    for (int d0 = 0; d0 < 4; ++d0) {
        const bf16x8 b0 = *(const ALAS bf16x8*)(kb + d0 * 2048);
        const bf16x8 b1 = *(const ALAS bf16x8*)(kb + d0 * 2048 + 512);
        if (d0 == 0) { p0 = __builtin_amdgcn_mfma_f32_32x32x16_bf16(b0, qr[0], c0, 0, 0, 0); p1 = __builtin_amdgcn_mfma_f32_32x32x16_bf16(b1, qr[0], c0, 0, 0, 0); }
        else { p0 = __builtin_amdgcn_mfma_f32_32x32x16_bf16(b0, qr[d0], p0, 0, 0, 0); p1 = __builtin_amdgcn_mfma_f32_32x32x16_bf16(b1, qr[d0], p1, 0, 0, 0); }
    }
}
__device__ __forceinline__ void pv(f32x16* o, int vb, bf16x8 pa0, bf16x8 pa1, bf16x8 pa2, bf16x8 pa3) {
#pragma unroll
    for (int d0 = 0; d0 < 2; ++d0) { s16x4 lo[4], hi[4];
#pragma unroll
        for (int ks = 0; ks < 4; ++ks) {
            asm volatile("ds_read_b64_tr_b16 %0,%1 offset:%c2" : "=&v"(lo[ks]) : "v"(vb), "i"(d0 * 4096 + ks * 1024) : "memory");
            asm volatile("ds_read_b64_tr_b16 %0,%1 offset:%c2" : "=&v"(hi[ks]) : "v"(vb), "i"(d0 * 4096 + ks * 1024 + 512) : "memory"); }
        asm volatile("s_waitcnt lgkmcnt(0)" ::: "memory"); __builtin_amdgcn_sched_barrier(0);
#define PK(k) (bf16x8){lo[k][0], lo[k][1], lo[k][2], lo[k][3], hi[k][0], hi[k][1], hi[k][2], hi[k][3]}
        o[d0] = __builtin_amdgcn_mfma_f32_32x32x16_bf16(pa0, PK(0), o[d0], 0, 0, 0);
        o[d0] = __builtin_amdgcn_mfma_f32_32x32x16_bf16(pa1, PK(1), o[d0], 0, 0, 0);
        o[d0] = __builtin_amdgcn_mfma_f32_32x32x16_bf16(pa2, PK(2), o[d0], 0, 0, 0);
        o[d0] = __builtin_amdgcn_mfma_f32_32x32x16_bf16(pa3, PK(3), o[d0], 0, 0, 0);
#undef PK
    }
}
#define PKP(P, B) cvtpk(P[B], P[B + 1])
__device__ __forceinline__ void pv_from(f32x16* o, int vb, const f32x16& p0, const f32x16& p1) {
    const u32x4 pw0 = (u32x4){PKP(p0, 0), PKP(p0, 2), PKP(p0, 4), PKP(p0, 6)}, pw1 = (u32x4){PKP(p0, 8), PKP(p0, 10), PKP(p0, 12), PKP(p0, 14)};
    const u32x4 pw2 = (u32x4){PKP(p1, 0), PKP(p1, 2), PKP(p1, 4), PKP(p1, 6)}, pw3 = (u32x4){PKP(p1, 8), PKP(p1, 10), PKP(p1, 12), PKP(p1, 14)};
    pv(o, vb, __builtin_bit_cast(bf16x8, pw0), __builtin_bit_cast(bf16x8, pw1), __builtin_bit_cast(bf16x8, pw2), __builtin_bit_cast(bf16x8, pw3));
}
#undef PKP
__device__ __forceinline__ void store_o(const f32x16* o, const float* rscale, ALAS char* shm, bf16_t* Yw, int ldy, int wid, int lane, int r32, int hi) {
    ALAS bf16_t* stg = (ALAS bf16_t*)(shm + L_OST) + wid * 2048;
#pragma unroll
    for (int r = 0; r < 16; ++r) { const int orow = crow(r, hi);
#pragma unroll
        for (int d0 = 0; d0 < 2; ++d0) { const float v = o[d0][r] * rscale[r]; stg[orow * 64 + d0 * 32 + r32] = (bf16_t)(cvtpk(v, v) & 0xffffu); } }
    asm volatile("s_waitcnt lgkmcnt(0)" ::: "memory");
#pragma unroll
    for (int i = 0; i < 4; ++i) { const int row = i * 8 + (lane >> 3), ch = lane & 7; const u32x4 v = *(const ALAS u32x4*)(stg + row * 64 + ch * 8); *(u32x4*)(Yw + (size_t)row * ldy + ch * 8) = v; }
    asm volatile("s_waitcnt lgkmcnt(0)" ::: "memory");
}

struct SbPre { bf16x8 qr[4]; u32x4 kreg, vreg; };
__device__ __forceinline__ void sb_prefetch(SbPre& P, int b, int h, int qb, const bf16_t* QKV, const int wid, const int lane) {
    const int r32 = lane & 31, hi = lane >> 5; const size_t rowbase = (size_t)b * SEQ; const int q0 = qb * 256; const int NT = (q0 + 256) / 64;
    const bf16_t* Qw = QKV + (rowbase + q0 + wid * 32) * LDQ + h * 64;
    const bf16_t* ksrc = QKV + rowbase * LDQ + 512 + h * 64 + (size_t)lane * LDQ + wid * 8;
    const bf16_t* vsrc = QKV + rowbase * LDQ + 1024 + h * 64 + (size_t)(16 * (wid & 3) + (lane >> 2)) * LDQ + (wid >> 2) * 32 + (lane & 3) * 8;
#pragma unroll
    for (int d0 = 0; d0 < 4; ++d0) P.qr[d0] = *(const bf16x8*)(Qw + (size_t)r32 * LDQ + d0 * 16 + hi * 8);
    P.kreg = *(const u32x4*)(ksrc + (size_t)(NT - 1) * 64 * LDQ); P.vreg = *(const u32x4*)(vsrc + (size_t)(NT - 1) * 64 * LDQ);
}
__device__ __forceinline__ void sb_unit(int b, int h, int qb, const bf16_t* QKV, bf16_t* Y, ALAS char* shm, const int wid, SbPre& P, bool has_next, int nb, int nh, int nqb) {
    const int lane = mk_lane(), tid = wid * 64 + lane, r32 = lane & 31, hi = lane >> 5;
    const size_t rowbase = (size_t)b * SEQ; const int q0 = qb * 256;
    const bf16_t* Qw = QKV + (rowbase + q0 + wid * 32) * LDQ + h * 64;
    const bf16_t* Kh = QKV + rowbase * LDQ + 512 + h * 64; const bf16_t* Vh = QKV + rowbase * LDQ + 1024 + h * 64;
    const bf16_t* ksrc = Kh + (size_t)lane * LDQ + wid * 8;
    const bf16_t* vsrc = Vh + (size_t)(16 * (wid & 3) + (lane >> 2)) * LDQ + (wid >> 2) * 32 + (lane & 3) * 8;
    const int stoff = wid * 1024 + lane * 16;
    const int vb0 = (int)(unsigned)(uintptr_t)(shm + L_V) + ((lane >> 4) & 1) * 32 + (lane & 3) * 8 + (4 * hi + ((lane & 15) >> 2)) * 64;
    ALAS unsigned* flags = (ALAS unsigned*)(shm + L_WS);
    bf16x8 qr[4];
#pragma unroll
    for (int d0 = 0; d0 < 4; ++d0) qr[d0] = P.qr[d0];
    const int NT = (q0 + 256) / 64;
    const int myt = q0 + wid * 32 + r32, wmax = q0 + wid * 32 + 31, wmin = q0 + wid * 32;
    float carry = 1.f; f32x16 o[2]; o[0] = f32x16{}; o[1] = f32x16{};
    u32x4 kreg = P.kreg, vreg = P.vreg;
    int slot = 0; bool alive = true;
    for (int jt = NT - 1; jt >= 0; --jt) {
        *(ALAS u32x4*)(shm + L_K + slot * SLOTB + stoff) = kreg; *(ALAS u32x4*)(shm + L_V + slot * SLOTB + stoff) = vreg;
        if (lane == 0) flags[slot * 8 + wid] = alive ? 1u : 0u;
        __syncthreads();
        { const u32x4 f0 = *(const ALAS u32x4*)(flags + slot * 8), f1 = *(const ALAS u32x4*)(flags + slot * 8 + 4);
          if (((f0.x | f0.y) | (f0.z | f0.w) | (f1.x | f1.y) | (f1.z | f1.w)) == 0u) break; }
        if (jt > 0) { kreg = *(const u32x4*)(ksrc + (size_t)(jt - 1) * 64 * LDQ); vreg = *(const u32x4*)(vsrc + (size_t)(jt - 1) * 64 * LDQ); }
        if (alive && 64 * jt < wmax) {
            f32x16 p0, p1; qkt(p0, p1, shm + L_K + slot * SLOTB, qr, r32, hi);
            const bool diag = (64 * jt + 63 >= wmin);
            f32x16 l0, l1;
            if (diag) {
#pragma unroll
                for (int r = 0; r < 16; ++r) {
                    { const float e = __builtin_amdgcn_exp2f(fminf(p0[r], 80.f)); float kp = __builtin_amdgcn_rcpf(1.0f + e); float be = e * kp;
                      if (!(64 * jt + crow(r, hi) < myt)) { kp = 1.f; be = 0.f; } l0[r] = kp; p0[r] = be; }
                    { const float e = __builtin_amdgcn_exp2f(fminf(p1[r], 80.f)); float kp = __builtin_amdgcn_rcpf(1.0f + e); float be = e * kp;
                      if (!(64 * jt + 32 + crow(r, hi) < myt)) { kp = 1.f; be = 0.f; } l1[r] = kp; p1[r] = be; }
                }
            } else {
#pragma unroll
                for (int r = 0; r < 16; ++r) {
                    { const float e = __builtin_amdgcn_exp2f(fminf(p0[r], 80.f)); const float kp = __builtin_amdgcn_rcpf(1.0f + e); l0[r] = kp; p0[r] = e * kp; }
                    { const float e = __builtin_amdgcn_exp2f(fminf(p1[r], 80.f)); const float kp = __builtin_amdgcn_rcpf(1.0f + e); l1[r] = kp; p1[r] = e * kp; }
                }
            }
            float run = carry;
#pragma unroll
            for (int g = 3; g >= 0; --g) {
                const float tm = (l1[4 * g] * l1[4 * g + 1]) * (l1[4 * g + 2] * l1[4 * g + 3]); float t0, t1; both_vals(tm, t0, t1);
                float pre = hi ? run : run * t1;
                p1[4 * g + 3] *= pre; pre *= l1[4 * g + 3]; p1[4 * g + 2] *= pre; pre *= l1[4 * g + 2]; p1[4 * g + 1] *= pre; pre *= l1[4 * g + 1]; p1[4 * g] *= pre;
                run = (run * t1) * t0;
            }
#pragma unroll
            for (int g = 3; g >= 0; --g) {
                const float tm = (l0[4 * g] * l0[4 * g + 1]) * (l0[4 * g + 2] * l0[4 * g + 3]); float t0, t1; both_vals(tm, t0, t1);
                float pre = hi ? run : run * t1;
                p0[4 * g + 3] *= pre; pre *= l0[4 * g + 3]; p0[4 * g + 2] *= pre; pre *= l0[4 * g + 2]; p0[4 * g + 1] *= pre; pre *= l0[4 * g + 1]; p0[4 * g] *= pre;
                run = (run * t1) * t0;
            }
            carry = run;
            pv_from(o, vb0 + slot * SLOTB, p0, p1);
            alive = !__all(carry == 0.f);
        }
        slot ^= 1;
    }
    if (has_next) sb_prefetch(P, nb, nh, nqb, QKV, wid, lane);
    float ones[16];
#pragma unroll
    for (int r = 0; r < 16; ++r) ones[r] = 1.0f;
    __syncthreads();
    store_o(o, ones, shm, Y + (rowbase + q0 + wid * 32) * 1024 + h * 64, 1024, wid, lane, r32, hi);
    __syncthreads();
}

__device__ __forceinline__ int cnt_ge8(const unsigned* u, unsigned c) {
    unsigned long long m0, m1, m2, m3, m4, m5, m6, m7;
    asm("v_cmp_ge_u32_e64 %0, %8, %16\n\tv_cmp_ge_u32_e64 %1, %9, %16\n\tv_cmp_ge_u32_e64 %2, %10, %16\n\tv_cmp_ge_u32_e64 %3, %11, %16\n\t"
        "v_cmp_ge_u32_e64 %4, %12, %16\n\tv_cmp_ge_u32_e64 %5, %13, %16\n\tv_cmp_ge_u32_e64 %6, %14, %16\n\tv_cmp_ge_u32_e64 %7, %15, %16"
        : "=&s"(m0), "=&s"(m1), "=&s"(m2), "=&s"(m3), "=&s"(m4), "=&s"(m5), "=&s"(m6), "=&s"(m7)
        : "v"(u[0]), "v"(u[1]), "v"(u[2]), "v"(u[3]), "v"(u[4]), "v"(u[5]), "v"(u[6]), "v"(u[7]), "v"(c));
    return (int)((__builtin_popcountll(m0) + __builtin_popcountll(m1)) + (__builtin_popcountll(m2) + __builtin_popcountll(m3)))
         + (int)((__builtin_popcountll(m4) + __builtin_popcountll(m5)) + (__builtin_popcountll(m6) + __builtin_popcountll(m7)));
}
__device__ __forceinline__ unsigned mono(float f) { const unsigned u = __float_as_uint(f + 0.0f); return u ^ ((u >> 31) ? 0xffffffffu : 0x80000000u); }
#define DPPI(v, ctrl) __builtin_amdgcn_update_dpp(0, (v), (ctrl), 0xf, 0xf, true)
#define DPPK(v, ctrl) __builtin_amdgcn_update_dpp((v), (v), (ctrl), 0xf, 0xf, false)
__device__ __forceinline__ int wave_incl_scan(int v, int lane) {
    v += DPPI(v, 0x111); v += DPPI(v, 0x112); v += DPPI(v, 0x114); v += DPPI(v, 0x118);
    const int t0 = __builtin_amdgcn_readlane(v, 15), t1 = __builtin_amdgcn_readlane(v, 31), t2 = __builtin_amdgcn_readlane(v, 47);
    const int row = lane >> 4; return v + (row >= 1 ? t0 : 0) + (row >= 2 ? t1 : 0) + (row >= 3 ? t2 : 0);
}
__device__ __forceinline__ int wave_max_i(int v) {
    v = max(v, DPPK(v, 0xB1)); v = max(v, DPPK(v, 0x4E)); v = max(v, DPPK(v, 0x124)); v = max(v, DPPK(v, 0x128));
    return max(max(__builtin_amdgcn_readlane(v, 0), __builtin_amdgcn_readlane(v, 16)), max(__builtin_amdgcn_readlane(v, 32), __builtin_amdgcn_readlane(v, 48)));
}
__device__ __forceinline__ float wave_max_f(float x) {
    int v = __float_as_int(x);
#define FMX(a, b) __float_as_int(fmaxf(__int_as_float(a), __int_as_float(b)))
    v = FMX(v, DPPK(v, 0xB1)); v = FMX(v, DPPK(v, 0x4E)); v = FMX(v, DPPK(v, 0x124)); v = FMX(v, DPPK(v, 0x128));
    const float r = fmaxf(fmaxf(__int_as_float(__builtin_amdgcn_readlane(v, 0)), __int_as_float(__builtin_amdgcn_readlane(v, 16))), fmaxf(__int_as_float(__builtin_amdgcn_readlane(v, 32)), __int_as_float(__builtin_amdgcn_readlane(v, 48))));
#undef FMX
    return r;
}
constexpr int L_HIST = 143360, L_CAND = 151552;
__device__ __forceinline__ void idx_load_aq(bf16x8 (&aq)[4][4], size_t rowbase, int qs0, const bf16_t* QKV, int r32, int hi) {
#pragma unroll
    for (int mt = 0; mt < 4; ++mt)
#pragma unroll
        for (int d0 = 0; d0 < 4; ++d0) aq[mt][d0] = *(const bf16x8*)(QKV + (rowbase + qs0 + 4 * mt + (r32 >> 3)) * LDQ + 2048 + (r32 & 7) * 64 + d0 * 16 + hi * 8);
}
__device__ __forceinline__ void idx_score16(const bf16x8 (&aq)[4][4], int b, int qs0, int qslot0, const bf16_t* QKV, ALAS char* shm, const int wid) {

    const int lane = mk_lane(), tid = wid * 64 + lane, r32 = lane & 31, hi = lane >> 5;
    const size_t rowbase = (size_t)b * SEQ;
    ALAS float* sc = (ALAS float*)(shm + L_SC); ALAS float* wl = (ALAS float*)(shm + L_WL) + qslot0 * 8; ALAS unsigned long long* maskL = (ALAS unsigned long long*)(shm + L_MASK);
    const int nkt = (qs0 + 15) / 32 + 1;
    {
    bf16x8 bkn[4];
    { const int kt0 = wid < nkt ? wid : 0;
#pragma unroll
      for (int d0 = 0; d0 < 4; ++d0) bkn[d0] = *(const bf16x8*)(QKV + (rowbase + 32 * kt0 + r32) * LDQ + 2688 + d0 * 16 + hi * 8); }
#ifdef REP_SCORE
#pragma unroll 1
    for (int rep_ = 0; rep_ < REP_SCORE; ++rep_)
#endif
    for (int kt = wid; kt < nkt; kt += 8) {
        bf16x8 bk[4];
#pragma unroll
        for (int d0 = 0; d0 < 4; ++d0) bk[d0] = bkn[d0];
        { const int ktn = kt + 8 < nkt ? kt + 8 : kt;
#pragma unroll
          for (int d0 = 0; d0 < 4; ++d0) bkn[d0] = *(const bf16x8*)(QKV + (rowbase + 32 * ktn + r32) * LDQ + 2688 + d0 * 16 + hi * 8); }
#pragma unroll
        for (int mt = 0; mt < 4; ++mt) {
            f32x16 c = f32x16{};
#pragma unroll
            for (int d0 = 0; d0 < 4; ++d0) c = __builtin_amdgcn_mfma_f32_32x32x16_bf16(aq[mt][d0], bk[d0], c, 0, 0, 0);
            float pq[4];
#pragma unroll
            for (int ql = 0; ql < 4; ++ql) {
                const f32x4 w4 = *(const ALAS f32x4*)(wl + (4 * mt + ql) * 8 + 4 * hi);
                float part = w4[0] * fmaxf(c[4 * ql], 0.f); part += w4[1] * fmaxf(c[4 * ql + 1], 0.f); part += w4[2] * fmaxf(c[4 * ql + 2], 0.f); part += w4[3] * fmaxf(c[4 * ql + 3], 0.f);
                pq[ql] = part;
            }
#pragma unroll
            for (int pr = 0; pr < 2; ++pr) {
                auto rr = __builtin_amdgcn_permlane32_swap(__float_as_uint(pq[2 * pr]), __float_as_uint(pq[2 * pr + 1]), false, false);
                sc[(4 * mt + 2 * pr + hi) * 2048 + 32 * kt + r32] = __uint_as_float(rr[0]) + __uint_as_float(rr[1]);
            }
        }
    }
    }
}
__device__ __forceinline__ void idx_sel16(int b, int qs0, int qslot0, int NTW, ALAS char* shm, const int wid) {

    const int lane = mk_lane(), tid = wid * 64 + lane, r32 = lane & 31, hi = lane >> 5;
    const size_t rowbase = (size_t)b * SEQ;
    ALAS float* sc = (ALAS float*)(shm + L_SC); ALAS float* wl = (ALAS float*)(shm + L_WL) + qslot0 * 8; ALAS unsigned long long* maskL = (ALAS unsigned long long*)(shm + L_MASK);
#ifdef REP_SEL
#pragma unroll 1
    for (int rep_ = 0; rep_ < REP_SEL; ++rep_)
#endif
#pragma unroll 1
    for (int qq = 0; qq < 2; ++qq) {
        const int q = 2 * wid + qq, t = qs0 + q; const int qs = qslot0 + q;
        if (t < 256) {
            for (int i = 0; i < NTW; ++i) { const unsigned long long w = __ballot(64 * i + lane <= t); if (lane == 0) maskL[i * 32 + qs] = w; }
        } else {
            float f[32]; int bq[32];
            const int nreg = (t >> 6) + 1;
            float lmin = 3.0e38f, lmax = -3.0e38f;
#pragma unroll
            for (int i = 0; i < 32; ++i) { f[i] = 0.f; bq[i] = -1; }
#pragma unroll
            for (int blk = 0; blk < 4; ++blk) if (8 * blk < nreg) {
#pragma unroll
                for (int i = 8 * blk; i < 8 * blk + 8; ++i) { const int key = lane + 64 * i; const bool valid = key <= t; f[i] = sc[q * 2048 + key] + 0.0f;
                    lmin = fminf(lmin, valid ? f[i] : 3.0e38f); lmax = fmaxf(lmax, valid ? f[i] : -3.0e38f); } }
            const float smax = wave_max_f(lmax), smin = -wave_max_f(-lmin);
            const float scale = smax > smin ? 255.99f / (smax - smin) : 0.f;
            ALAS unsigned* hist = (ALAS unsigned*)(shm + L_HIST) + wid * 256;
            *(ALAS u32x4*)(hist + 4 * lane) = (u32x4){0u, 0u, 0u, 0u};
#pragma unroll
            for (int blk = 0; blk < 4; ++blk) if (8 * blk < nreg) {
#pragma unroll
                for (int i = 8 * blk; i < 8 * blk + 8; ++i) { const int key = lane + 64 * i; const bool valid = key <= t;
                    int bi = (int)((f[i] - smin) * scale); bi = bi > 255 ? 255 : bi; bq[i] = valid ? bi : -1;
                    if (valid) __hip_atomic_fetch_add(hist + bi, 1u, __ATOMIC_RELAXED, __HIP_MEMORY_SCOPE_WORKGROUP); } }
            const u32x4 c4 = *(const ALAS u32x4*)(hist + 4 * lane);
            const int lsum4 = (int)(c4.x + c4.y + c4.z + c4.w);
            const int pin = wave_incl_scan(lsum4, lane); const int total = __builtin_amdgcn_readlane(pin, 63);
            const int S3 = total - pin + (int)c4.w, S2 = S3 + (int)c4.z, S1 = S2 + (int)c4.y, S0 = S1 + (int)c4.x;
            const int bl = S3 >= 256 ? 4 * lane + 3 : S2 >= 256 ? 4 * lane + 2 : S1 >= 256 ? 4 * lane + 1 : S0 >= 256 ? 4 * lane : -1;
            const int bstar = wave_max_i(bl);
            const int jb = bstar & 3;
            const int Sj = jb == 3 ? S3 : jb == 2 ? S2 : jb == 1 ? S1 : S0, cj = (int)(jb == 3 ? c4.w : jb == 2 ? c4.z : jb == 1 ? c4.y : c4.x);
            const int C = __builtin_amdgcn_readlane(cj, bstar >> 2), need = 256 - (__builtin_amdgcn_readlane(Sj, bstar >> 2) - C);
            if (C <= 64) {
                ALAS float* cs = (ALAS float*)(shm + L_CAND) + wid * 128; ALAS int* ck = (ALAS int*)(cs + 64);
                int cl = 0;
#pragma unroll
                for (int i = 0; i < 32; ++i) cl += (bq[i] == bstar) ? 1 : 0;
                int pos = wave_incl_scan(cl, lane) - cl;
                unsigned wlo = 0u, whi = 0u;
#pragma unroll
                for (int blk = 0; blk < 4; ++blk) if (8 * blk < nreg) {
#pragma unroll
                    for (int i = 8 * blk; i < 8 * blk + 8; ++i) {
                        if (bq[i] == bstar) { cs[pos] = f[i]; ck[pos] = lane + 64 * i; ++pos; }
                        const unsigned long long w = __ballot(bq[i] > bstar);
                        asm volatile("s_nop 4\n\tv_writelane_b32 %0, %2, %4\n\tv_writelane_b32 %1, %3, %4" : "+v"(wlo), "+v"(whi) : "s"((unsigned)w), "s"((unsigned)(w >> 32)), "n"(i)); } }
                if (lane < NTW) maskL[lane * 32 + qs] = ((unsigned long long)whi << 32) | wlo;
                const int jl = lane < C ? lane : 0; const float sj = cs[jl]; const int kj = ck[jl];
                int rank = 0;
                for (int m = 0; m < C; ++m) { const float sm = cs[m]; const int km = ck[m]; rank += (sm > sj || (sm == sj && km < kj)) ? 1 : 0; }
                if (lane < C && rank < need)
                    __hip_atomic_fetch_or((ALAS unsigned*)maskL + (((kj >> 6) * 32 + qs) * 2 + ((kj >> 5) & 1)), 1u << (kj & 31), __ATOMIC_RELAXED, __HIP_MEMORY_SCOPE_WORKGROUP);
            } else {
            unsigned u[32];
#pragma unroll
            for (int i = 0; i < 32; ++i) { const int key = lane + 64 * i; u[i] = (key <= t) ? mono(f[i]) : 0u; }
            unsigned thr = 0u; bool exact = false;
#pragma unroll 1
            for (int bit = 31; bit >= 0; --bit) {
                const unsigned cand = thr | (1u << bit);
                int cnt = cnt_ge8(u, cand);
                if (nreg > 8) cnt += cnt_ge8(u + 8, cand);
                if (nreg > 16) cnt += cnt_ge8(u + 16, cand);
                if (nreg > 24) cnt += cnt_ge8(u + 24, cand);
                if (cnt >= 256) { thr = cand; if (cnt == 256) { exact = true; break; } }
            }
            int need = 0;
            if (!exact) { int cgt = 0;
#pragma unroll
                for (int i = 0; i < 32; ++i) cgt += __builtin_popcountll(__ballot(u[i] > thr));
                need = 256 - cgt; }
            int seen = 0;
#pragma unroll
            for (int i = 0; i < 32; ++i) {
                unsigned long long w;
                if (exact) w = __ballot(u[i] >= thr);
                else { const unsigned long long eqm = __ballot(u[i] == thr); const int rank = seen + (int)__builtin_popcountll(eqm & ((1ull << lane) - 1ull));
                       w = __ballot(u[i] > thr || (u[i] == thr && rank < need)); seen += (int)__builtin_popcountll(eqm); }
                if (i < NTW && lane == 0) maskL[i * 32 + qs] = w;
            }
            }
        }
    }
    }

struct DsPre { float wlv; };
__device__ __forceinline__ void dsa_prefetch(DsPre& P, int b, int qblk, const bf16_t* QKV, const float* wi, const int wid, const int lane) {
    const int tid = wid * 64 + lane, r32 = lane & 31, hi = lane >> 5; const size_t rowbase = (size_t)b * SEQ; const int q0 = qblk * 32;
    P.wlv = tid < 256 ? wi[(rowbase + q0) * 8 + tid] : 0.f;
}
__device__ __forceinline__ void dsa_unit(int b, int qblk, const bf16_t* QKV, const float* wi, bf16_t* Y, ALAS char* shm, const int wid, DsPre& P, bool has_next, int nb, int nqblk) {
    const int lane = mk_lane(), tid = wid * 64 + lane, r32 = lane & 31, hi = lane >> 5;
    const size_t rowbase = (size_t)b * SEQ; const int q0 = qblk * 32; const int NT = q0 / 64 + 1;
    bf16x8 aq[4][4];
    idx_load_aq(aq, rowbase, q0, QKV, r32, hi);
    if (tid < 256) ((ALAS float*)(shm + L_WL))[tid] = P.wlv;
    __syncthreads();
    idx_score16(aq, b, q0, 0, QKV, shm, wid);
    __syncthreads();
    idx_load_aq(aq, rowbase, q0 + 16, QKV, r32, hi);
    idx_sel16(b, q0, 0, NT, shm, wid);
    __syncthreads();
    idx_score16(aq, b, q0 + 16, 16, QKV, shm, wid);
    __syncthreads();
    const bf16_t* Qw = QKV + (rowbase + q0) * LDQ + 1536 + wid * 64;
    const bf16_t* Kh = QKV + rowbase * LDQ + 2560; const bf16_t* Vh = QKV + rowbase * LDQ + 2624;
    const bf16_t* ksrc = Kh + (size_t)lane * LDQ + wid * 8;
    const bf16_t* vsrc = Vh + (size_t)(16 * (wid & 3) + (lane >> 2)) * LDQ + (wid >> 2) * 32 + (lane & 3) * 8;
    bf16x8 qr[4];
#pragma unroll
    for (int d0 = 0; d0 < 4; ++d0) qr[d0] = *(const bf16x8*)(Qw + (size_t)r32 * LDQ + d0 * 16 + hi * 8);
    u32x4 kreg = *(const u32x4*)(ksrc), vreg = *(const u32x4*)(vsrc);
    idx_sel16(b, q0 + 16, 16, NT, shm, wid);
    __syncthreads();
    const ALAS unsigned long long* maskL = (const ALAS unsigned long long*)(shm + L_MASK);
    ALAS float* wsf = (ALAS float*)(shm + L_WS) + wid * 64;
    const int stoff = wid * 1024 + lane * 16;
    const int vb0 = (int)(unsigned)(uintptr_t)(shm + L_V) + ((lane >> 4) & 1) * 32 + (lane & 3) * 8 + (4 * hi + ((lane & 15) >> 2)) * 64;
    float mrun = 0.f, lsum = 0.f; bool seen = false; f32x16 o[2]; o[0] = f32x16{}; o[1] = f32x16{}; f32x16 negm = f32x16{};
    int slot = 0;
    for (int jt = 0; jt < NT; ++jt) {
        *(ALAS u32x4*)(shm + L_K + slot * SLOTB + stoff) = kreg; *(ALAS u32x4*)(shm + L_V + slot * SLOTB + stoff) = vreg;
        __syncthreads();
        if (jt + 1 < NT) { kreg = *(const u32x4*)(ksrc + (size_t)(jt + 1) * 64 * LDQ); vreg = *(const u32x4*)(vsrc + (size_t)(jt + 1) * 64 * LDQ); }
        const unsigned long long mw = maskL[jt * 32 + r32];
        const unsigned mlo = (unsigned)mw >> (4 * hi), mhi = (unsigned)(mw >> 32) >> (4 * hi);
        f32x16 p0, p1; qkt_c(p0, p1, shm + L_K + slot * SLOTB, qr, negm, r32, hi);
        float mx = -1e30f;
#pragma unroll
        for (int r = 0; r < 16; ++r) { const unsigned bitp = (r & 3) + 8 * (r >> 2);
            const unsigned s0 = (unsigned)__builtin_amdgcn_sbfe((int)mlo, bitp, 1u), s1 = (unsigned)__builtin_amdgcn_sbfe((int)mhi, bitp, 1u);
            p0[r] = __uint_as_float((__float_as_uint(p0[r]) & s0) | (0xf149f2cau & ~s0)); p1[r] = __uint_as_float((__float_as_uint(p1[r]) & s1) | (0xf149f2cau & ~s1));
            mx = fmaxf(fmaxf(mx, p0[r]), p1[r]); }
        mx = both_max(mx);
        const bool has = mx > -1e29f;
        const float dl = has ? (seen ? (mx > 4.0f ? mx : 0.f) : mx) : 0.f;
        if (__any(dl != 0.f)) {
            const float f = seen ? __builtin_amdgcn_exp2f(-dl) : 1.0f;
            lsum *= f;
            if (hi == 0) wsf[r32] = f;
            asm volatile("s_waitcnt lgkmcnt(0)" ::: "memory");
#pragma unroll
            for (int r = 0; r < 16; ++r) { const float fr = wsf[crow(r, hi)]; o[0][r] *= fr; o[1][r] *= fr; }
            mrun += dl;
#pragma unroll
            for (int r = 0; r < 16; ++r) { p0[r] -= dl; p1[r] -= dl; negm[r] = -mrun; }
        }
        seen = seen || has;
        float ps = 0.f;
#pragma unroll
        for (int r = 0; r < 16; ++r) { p0[r] = __builtin_amdgcn_exp2f(p0[r]); p1[r] = __builtin_amdgcn_exp2f(p1[r]); ps += p0[r] + p1[r]; }
        lsum += ps;
        pv_from(o, vb0 + slot * SLOTB, p0, p1);
        slot ^= 1;
    }
    if (has_next) dsa_prefetch(P, nb, nqblk, QKV, wi, wid, lane);
    lsum = both_sum(lsum);
    if (hi == 0) wsf[32 + r32] = lsum;
    asm volatile("s_waitcnt lgkmcnt(0)" ::: "memory");
    float rli[16];
#pragma unroll
    for (int r = 0; r < 16; ++r) rli[r] = __builtin_amdgcn_rcpf(wsf[32 + crow(r, hi)]);
    store_o(o, rli, shm, Y + (rowbase + q0) * 1024 + 512 + wid * 64, 1024, wid, lane, r32, hi);
    __syncthreads();
}
#undef ALAS
}
#ifndef MK_N_LAUNCHES
#define MK_N_LAUNCHES 1
#endif
#ifndef REP_SB
#define REP_SB 1
#endif
#ifndef REP_DSA
#define REP_DSA 1
#endif
#ifndef REP_P1
#define REP_P1 1
#endif
#ifndef REP_P2
#define REP_P2 1
#endif
#ifndef REP_P3
#define REP_P3 1
#endif
constexpr int NWAVES = 8, NPHASE = 11;
constexpr int T = 32768, SEQ = 2048, D = 1024, DFF = 2816, NIN = 4808, NINV = 4864, PLE = 256;
#define LAS __attribute__((address_space(3)))
typedef unsigned short bf16;
typedef unsigned v4u __attribute__((ext_vector_type(4)));
typedef float f32x4 __attribute__((ext_vector_type(4)));
constexpr size_t MiB = 1u << 20;
constexpr size_t WS_CTL = 11 * MiB, CTL_BYTES = 16384;
constexpr size_t WS_SSX = 0, WS_SS1 = 2 * MiB, WS_SS2 = 4 * MiB, WS_SS3 = 6 * MiB, WS_ROT = 8 * MiB, WS_WI = 10 * MiB;
constexpr size_t WS_W1A = 20 * MiB, WS_W2A = 31 * MiB, WS_WIN = 37 * MiB, WS_WOA = 47 * MiB, WS_WOB = 48 * MiB, WS_WOUT = 49 * MiB, WS_W1B = 51 * MiB, WS_W2B = 62 * MiB, WS_WPG = 68 * MiB, WS_WPP = 70 * MiB;
constexpr size_t WS_HB0 = 72 * MiB, WS_HB1 = 136 * MiB, WS_BIG = 200 * MiB, WS_GATES = 376 * MiB, WS_END = 504 * MiB;
constexpr int RING_BYTES = 131072, LDS_BYTES = 155648 + 4096, RTAB_OFF = 141312;
#define LDS_WAIT() asm volatile("s_waitcnt lgkmcnt(0)" ::: "memory")
__device__ __forceinline__ unsigned f2bf(float f) { unsigned u = __builtin_bit_cast(unsigned, f); return (u + 0x7fffu + ((u >> 16) & 1u)) >> 16; }
__device__ __forceinline__ unsigned pk2(float lo, float hi) { return f2bf(lo) | (f2bf(hi) << 16); }
__device__ __forceinline__ float wave_sum(float v) {
#pragma unroll
    for (int o = 1; o < 64; o <<= 1) v += __shfl_xor(v, o);
    return v;
}
__device__ __forceinline__ int rotp(int c) { return c < 8 ? 2 * c : (c < 16 ? 2 * (c - 8) + 1 : c); }
template <int MODE> __device__ __forceinline__ int vmap(int n) {
    if (MODE == 0) return n;
    if (MODE == 1) { const int j = n < DFF ? n : n - DFF; return (j >> 7) * 256 + (n < DFF ? 0 : 128) + (j & 127); }
    if (n < 1536) return n;
    if (n < 2048) { const int m = n - 1536; return 1536 + (m & ~63) + rotp(m & 63); }
    if (n < 2112) return 2560 + rotp(n - 2048);
    if (n < 2176) return 2624 + (n - 2112);
    if (n < 2688) { const int m = n - 2176; return 2048 + (m & ~63) + rotp(m & 63); }
    if (n < 2752) return 2688 + rotp(n - 2688);
    if (n < 2760) return n;
    if (n < 3784) return 2816 + (n - 2760);
    return 3840 + (n - 3784);
}
template <int MODE> __device__ __forceinline__ void transpose_item(const float* W, int K, int N, bf16* WT, const float* gain, LAS float* scr, int item, int lane, int ldk = 0, int koff = 0) {
    if (ldk == 0) ldk = K;
    const int nblk = (N + 31) / 32, kb = item / nblk, nb = item % nblk, k0 = 64 * kb, n0 = 32 * nb;
    const int nq = n0 + (lane & 7) * 4; f32x4 v[8];
#pragma unroll
    for (int i = 0; i < 8; ++i) { const int kk = 8 * i + (lane >> 3); v[i] = (f32x4){0.f, 0.f, 0.f, 0.f}; if (nq < N) v[i] = __builtin_nontemporal_load((const f32x4*)(W + (size_t)(k0 + kk) * N + nq)); }
#pragma unroll
    for (int i = 0; i < 8; ++i) { const int kk = 8 * i + (lane >> 3); if (gain) v[i] = v[i] * gain[k0 + kk];
        LAS float* d = scr + kk * 33 + (lane & 7) * 4; d[0] = v[i][0]; d[1] = v[i][1]; d[2] = v[i][2]; d[3] = v[i][3]; }
    LDS_WAIT(); asm volatile("" ::: "memory");
    const int c = lane & 7;
#pragma unroll
    for (int j = 0; j < 4; ++j) { const int nl = (lane >> 3) + 8 * j; const LAS float* s = scr + (8 * c) * 33 + nl;
        if (n0 + nl < N) { v4u o; o.x = pk2(s[0 * 33], s[1 * 33]); o.y = pk2(s[2 * 33], s[3 * 33]); o.z = pk2(s[4 * 33], s[5 * 33]); o.w = pk2(s[6 * 33], s[7 * 33]);
            *(v4u*)(WT + (size_t)vmap<MODE>(n0 + nl) * ldk + koff + k0 + 8 * c) = o; } }
    LDS_WAIT(); asm volatile("" ::: "memory");
}

#define XB_TMO      128
#define XB_XCNT(j)  (256  + 64 * (j))
#define XB_XSUB(j)  (1280 + 64 * (j))
#define XB_XGEN(j)  (2304 + 64 * (j))
#define XB_TOP      3328
#define XB_TOPGEN   3392
#define XCD_BAR_WORDS 3456
#define XB_SPIN_CAP (1u << 18)

__device__ __forceinline__ unsigned xb_ld(unsigned* p)              { return __hip_atomic_load(p, __ATOMIC_RELAXED, __HIP_MEMORY_SCOPE_AGENT); }
__device__ __forceinline__ unsigned xb_add(unsigned* p, unsigned v) { return __hip_atomic_fetch_add(p, v, __ATOMIC_RELAXED, __HIP_MEMORY_SCOPE_AGENT); }
__device__ __forceinline__ unsigned xb_xcc_id() { return (unsigned)__builtin_amdgcn_s_getreg((3 << 11) | 20) & 0xFu; }
#define XB_SPIN(cond, bar) do { unsigned _sp = 0; while (cond) { __builtin_amdgcn_s_sleep(1); \
    if ((++_sp & 255u) == 0u) { if (xb_ld(&(bar)[XB_TMO])) break; if (_sp > XB_SPIN_CAP) { atomicAdd(&(bar)[XB_TMO], 1u); break; } } } } while (0)

struct XcdBarrier {
    unsigned* bar; unsigned x;
    volatile LAS unsigned* st;
};

__device__ __forceinline__ XcdBarrier xcd_barrier_post(unsigned* bar, volatile LAS unsigned* st, bool leader) {
    XcdBarrier b; b.bar = bar; b.x = xb_xcc_id(); b.st = st;
    if (leader) (void)xb_add(&bar[XB_XCNT(b.x)], 1u);
    return b;
}
__device__ __forceinline__ void xcd_barrier_complete(unsigned* bar, unsigned x, unsigned& nloc, unsigned& nx) {
    const unsigned G = gridDim.x * gridDim.y * gridDim.z;
    unsigned sum, cnt, mine, sp = 0u;
    for (;;) {
        sum = 0u; cnt = 0u; mine = 0u;
#pragma unroll
        for (unsigned j = 0; j < 16; ++j) { const unsigned c = xb_ld(&bar[XB_XCNT(j)]); sum += c; cnt += (c > 0u) ? 1u : 0u; mine = (j == x) ? c : mine; }
        if (sum == G) break;
        __builtin_amdgcn_s_sleep(1);
        if ((++sp & 255u) == 0u) { if (xb_ld(&bar[XB_TMO])) break; if (sp > XB_SPIN_CAP) { atomicAdd(&bar[XB_TMO], 1u); break; } }
    }
    nloc = mine > 0u ? mine : 1u; nx = cnt > 0u ? cnt : 1u;
}

__device__ __forceinline__ void xcd_barrier(const XcdBarrier& b, bool leader) {
    asm volatile("s_waitcnt vmcnt(0)" ::: "memory");
    __syncthreads();
    if (leader) {
        unsigned* bar = b.bar;
        __builtin_amdgcn_s_waitcnt(0);
        unsigned nloc = b.st[0], nx = b.st[1];
        if (nloc == 0u) { xcd_barrier_complete(bar, b.x, nloc, nx); b.st[0] = nloc; b.st[1] = nx; }
        const unsigned old = xb_add(&bar[XB_XSUB(b.x)], 1u);
        const unsigned gen = old / nloc;
        if (old + 1u == (gen + 1u) * nloc) {
            __builtin_amdgcn_fence(__ATOMIC_RELEASE, "agent");
            asm volatile("s_waitcnt vmcnt(0)" ::: "memory");
            const unsigned og = xb_add(&bar[XB_TOP], 1u);
            const unsigned tg = og / nx;
            if (og + 1u == (tg + 1u) * nx) xb_add(&bar[XB_TOPGEN], 1u);
            else XB_SPIN(xb_ld(&bar[XB_TOPGEN]) == tg, bar);
            __builtin_amdgcn_fence(__ATOMIC_ACQUIRE, "agent");
            xb_add(&bar[XB_XGEN(b.x)], 1u);
            asm volatile("s_waitcnt vmcnt(0)" ::: "memory");
        } else {
            XB_SPIN(xb_ld(&bar[XB_XGEN(b.x)]) == gen, bar);
            __builtin_amdgcn_fence(__ATOMIC_ACQUIRE, "agent");
            asm volatile("s_waitcnt vmcnt(0)" ::: "memory");
        }
    }
    __syncthreads();
}

struct Args { const float* in[18]; float* out; unsigned char* ws; float inv_freq[8]; int ph_lo, ph_hi; };

__global__ void __launch_bounds__(NWAVES * 64, 2) mk_fwd(Args args) {
    extern __shared__ __attribute__((aligned(16))) unsigned char lds_raw[];
    LAS unsigned char* lds = (LAS unsigned char*)lds_raw;
    int wave_ = __builtin_amdgcn_readfirstlane(threadIdx.x >> 6); asm volatile("" : "+s"(wave_)); const int wave = wave_;
#define tid (wave * 64 + mk_lane())
#define lane mk_lane()
    const int G = gridDim.x, bx = blockIdx.x; const int vcu = (G % 8 == 0) ? (bx % 8) * (G / 8) + bx / 8 : bx;
    unsigned char* ws = args.ws;
    const float* x = args.in[0]; const float* pin = args.in[1]; const int* positions = (const int*)args.in[2];
    float* out = args.out;
    float* ssx = (float*)(ws + WS_SSX); float* ss1 = (float*)(ws + WS_SS1); float* ss2 = (float*)(ws + WS_SS2); float* ss3 = (float*)(ws + WS_SS3);
    float* rot = (float*)(ws + WS_ROT); float* wi = (float*)(ws + WS_WI);
    bf16 *W1a = (bf16*)(ws + WS_W1A), *W2a = (bf16*)(ws + WS_W2A), *Win = (bf16*)(ws + WS_WIN), *WoA = (bf16*)(ws + WS_WOA), *WoB = (bf16*)(ws + WS_WOB), *Wout = (bf16*)(ws + WS_WOUT);
    bf16 *W1b = (bf16*)(ws + WS_W1B), *W2b = (bf16*)(ws + WS_W2B), *Wpg = (bf16*)(ws + WS_WPG), *Wpp = (bf16*)(ws + WS_WPP);
    bf16 *HB0 = (bf16*)(ws + WS_HB0), *HB1 = (bf16*)(ws + WS_HB1), *BIG = (bf16*)(ws + WS_BIG), *GATES = (bf16*)(ws + WS_GATES);
    bf16 *ysb = HB0, *ydsa = HB0;
    bf16 *tmpb = BIG, *mergedb = BIG + (size_t)T * 1024;
    bf16 *AC = GATES;
    if (args.ph_lo == -12345) cg::this_grid().sync();
    volatile LAS unsigned* xst = (volatile LAS unsigned*)(lds + 140288);
    if (wave == 0 && mk_lane() == 0) { xst[0] = 0u; xst[1] = 0u; }
    __syncthreads();
    XcdBarrier xbar = xcd_barrier_post((unsigned*)(ws + WS_CTL), xst, wave == 0 && mk_lane() == 0);
    const int lo = args.ph_lo, hi = args.ph_hi;
#ifndef PHASE_MASK
#define PHASE_MASK 0x7ff
#endif
#define IN(k) (((PHASE_MASK >> (k)) & 1) && lo <= (k) && (k) < hi)
#define SEAM(k) do { if (IN(k) && IN((k) + 1)) xcd_barrier(xbar, wave == 0 && mk_lane() == 0); } while (0)
    const int gw = vcu * NWAVES + wave, NGW = G * NWAVES;
    const int gt = vcu * NWAVES * 64 + tid, NGT = G * NWAVES * 64;

    if (IN(0)) {
        LAS float* scr = (LAS float*)(lds + wave * 16384);
        constexpr int I_1 = 16 * 176, I_2 = 44 * 32, I_IN = 16 * 151, I_OA = 8 * 32, I_O = 16 * 32, I_PP = 4 * 32;
        constexpr int NITEMS = 2 * I_1 + 2 * I_2 + I_IN + 2 * I_OA + 2 * I_O + I_PP;
        for (int it = gw; it < NITEMS; it += NGW) {
            int r = it;
            if (r < I_1) { transpose_item<1>(args.in[4], D, 2 * DFF, W1a, args.in[3], scr, r, lane); continue; } r -= I_1;
            if (r < I_1) { transpose_item<1>(args.in[12], D, 2 * DFF, W1b, args.in[11], scr, r, lane); continue; } r -= I_1;
            if (r < I_2) { transpose_item<0>(args.in[5], DFF, D, W2a, nullptr, scr, r, lane); continue; } r -= I_2;
            if (r < I_2) { transpose_item<0>(args.in[13], DFF, D, W2b, nullptr, scr, r, lane); continue; } r -= I_2;
            if (r < I_IN) { transpose_item<2>(args.in[7], D, NIN, Win, args.in[6], scr, r, lane); continue; } r -= I_IN;
            if (r < I_OA) { transpose_item<0>(args.in[8], 512, D, WoA, nullptr, scr, r, lane, 1024, 0); continue; } r -= I_OA;
            if (r < I_OA) { transpose_item<0>(args.in[9], 512, D, WoA, nullptr, scr, r, lane, 1024, 512); continue; } r -= I_OA;
            if (r < I_O) { transpose_item<0>(args.in[10], D, D, Wout, nullptr, scr, r, lane); continue; } r -= I_O;
            if (r < I_O) { transpose_item<0>(args.in[15], D, D, Wpg, args.in[14], scr, r, lane, 1280, 256); continue; } r -= I_O;
            transpose_item<0>(args.in[16], PLE, D, Wpg, nullptr, scr, r, lane, 1280, 0);
        }
        for (int i = gt; i < 56 * D / 8; i += NGT) *(v4u*)(Win + (size_t)2760 * D + (size_t)i * 8) = (v4u){0u, 0u, 0u, 0u};
        for (int m = gw; m < T; m += NGW) {
            const f32x4* xr = (const f32x4*)(x + (size_t)m * D) + lane; unsigned long long* o8 = (unsigned long long*)(HB0 + (size_t)m * D) + lane; float s = 0.f;
#pragma unroll
            for (int j = 0; j < 4; ++j) { const f32x4 v = __builtin_nontemporal_load(xr + 64 * j); s += (v[0] * v[0] + v[1] * v[1]) + (v[2] * v[2] + v[3] * v[3]); o8[64 * j] = (unsigned long long)pk2(v[0], v[1]) | ((unsigned long long)pk2(v[2], v[3]) << 32); }
            s = wave_sum(s);
            if (lane < 16) ssx[(size_t)m * 16 + lane] = lane == 0 ? s : 0.f;
        }
        for (int i = gt; i < T * 8; i += NGT) {
            const int c = i & 7; const float ang = (float)positions[i >> 3] * args.inv_freq[c];
            double rev = (double)ang * 0.15915494309189535; rev -= floor(rev); const float fr = (float)rev;
            rot[2 * i] = __builtin_amdgcn_cosf(fr); rot[2 * i + 1] = __builtin_amdgcn_sinf(fr);
        }
    }
    SEAM(0);
    if (IN(1)) { pg8::Gemm g{HB0, W1a, T, 2 * DFF, D}; pg8::StaticOrder S; S.init(T, 2 * DFF, G, bx); pg8::EpiSwiGLU E{BIG, DFF, pg8::build_rstd_tab((LAS float*)(lds + RTAB_OFF), ssx, S, wave)};
        pg8::gemm_phase<pg8::EpiSwiGLU, pg8::StaticOrder, true, true>(lds, g, S, E, wave); }
    SEAM(1);
    if (IN(2)) { pg8::Gemm g{BIG, W2a, T, D, DFF}; pg8::StaticOrder S; S.init(T, D, G, bx); pg8::EpiResid<false> E{HB0, HB1, ss1, 0.5f, 1024};
        pg8::gemm_phase<pg8::EpiResid<false>, pg8::StaticOrder, true, true>(lds, g, S, E, wave); }
    SEAM(2);
    if (IN(3)) { pg8::Gemm g{HB1, Win, T, NINV, D}; pg8::StaticOrder S; S.init(T, NINV, G, bx);
        pg8::EpiWin E{BIG, GATES, wi, pg8::build_rstd_tab((LAS float*)(lds + RTAB_OFF), ss1, S, wave), rot, 0.125f * 1.4426950408889634f, 0.125f * 0.35355339059327373f};
        pg8::gemm_phase<pg8::EpiWin, pg8::StaticOrder, true, true>(lds, g, S, E, wave); }
    SEAM(3);
    if (IN(4)) {
        if (wave >= 4) __builtin_amdgcn_s_setprio(1);
        { att::SbPre P; int k = 0; int pi = vcu; bool ok = pi < 512;
          if (ok) att::sb_prefetch(P, (pi >> 2) >> 3, (pi >> 2) & 7, 7 - (pi & 3), BIG, wave, mk_lane());
          while (ok) { const int bh = pi >> 2, s = pi & 3; const int qb = (k & 1) ? s : 7 - s;
              const int k2 = k + 1; const int pi2 = vcu + (k2 >> 1) * G; const bool ok2 = pi2 < 512; const int bh2 = pi2 >> 2, s2 = pi2 & 3; const int qb2 = (k2 & 1) ? s2 : 7 - s2;
              att::sb_unit(bh >> 3, bh & 7, qb, BIG, ysb, (LAS char*)lds, wave, P, ok2, bh2 >> 3, bh2 & 7, qb2);
              k = k2; pi = pi2; ok = ok2; } }
        { att::DsPre P; int k = 0; int pi = vcu; bool ok = pi < 512;
          if (ok) att::dsa_prefetch(P, pi >> 5, 63 - (pi & 31), BIG, wi, wave, mk_lane());
          while (ok) { const int b = pi >> 5, i = pi & 31; const int qblk = (k & 1) ? i : 63 - i;
              const int k2 = k + 1; const int pi2 = vcu + (k2 >> 1) * G; const bool ok2 = pi2 < 512; const int b2 = pi2 >> 5, i2 = pi2 & 31; const int qblk2 = (k2 & 1) ? i2 : 63 - i2;
              att::dsa_unit(b, qblk, BIG, wi, ydsa, (LAS char*)lds, wave, P, ok2, b2, qblk2);
              k = k2; pi = pi2; ok = ok2; } }
        __builtin_amdgcn_s_setprio(0);
    }
    SEAM(4);
    if (IN(5)) { pg8::Gemm g{ysb, WoA, T, D, D}; pg8::StaticOrder S; S.init(T, D, G, bx); pg8::EpiMerge E{GATES, mergedb};
        pg8::gemm_phase<pg8::EpiMerge, pg8::StaticOrder, true, true>(lds, g, S, E, wave); }
    SEAM(5);
    if (IN(6)) {
        for (int i = gt; i < T * PLE / 8; i += NGT) { const f32x4 a = *(const f32x4*)(pin + (size_t)i * 8), b = *(const f32x4*)(pin + (size_t)i * 8 + 4);
            *(v4u*)(AC + (size_t)(i >> 5) * 1280 + (i & 31) * 8) = (v4u){pk2(a[0], a[1]), pk2(a[2], a[3]), pk2(b[0], b[1]), pk2(b[2], b[3])}; }
        pg8::Gemm g{mergedb, Wout, T, D, D}; pg8::StaticOrder S; S.init(T, D, G, bx); pg8::EpiResid<false> E{HB1, HB1, ss2, 1.0f, 1024};
        pg8::gemm_phase<pg8::EpiResid<false>, pg8::StaticOrder, true, true>(lds, g, S, E, wave);
    }
    SEAM(6);
    if (IN(7)) { pg8::Gemm g{HB1, W1b, T, 2 * DFF, D}; pg8::StaticOrder S; S.init(T, 2 * DFF, G, bx); pg8::EpiSwiGLU E{BIG, DFF, pg8::build_rstd_tab((LAS float*)(lds + RTAB_OFF), ss2, S, wave)};
        pg8::gemm_phase<pg8::EpiSwiGLU, pg8::StaticOrder, true, true>(lds, g, S, E, wave); }
    SEAM(7);
    if (IN(8)) { pg8::Gemm g{BIG, W2b, T, D, DFF}; pg8::StaticOrder S; S.init(T, D, G, bx); pg8::EpiResid<false> E{HB1, AC + 256, ss3, 0.5f, 1280};
        pg8::gemm_phase<pg8::EpiResid<false>, pg8::StaticOrder, true, true>(lds, g, S, E, wave); }
    SEAM(8);
    if (IN(9)) { pg8::Gemm g{AC, Wpg, T, D, 1280}; pg8::StaticOrder S; S.init(T, D, G, bx);
        pg8::EpiPleM E{AC + 256, 1280, HB0, tmpb, ssx, pg8::build_rstd_tab((LAS float*)(lds + RTAB_OFF), ss3, S, wave)};
        pg8::gemm_phase<pg8::EpiPleM, pg8::StaticOrder, true, true>(lds, g, S, E, wave); }
    SEAM(9);
    if (IN(10)) {
        const f32x4* gr = (const f32x4*)args.in[17] + 2 * lane; f32x4 gv[4];
#pragma unroll
        for (int j = 0; j < 2; ++j) { gv[2 * j] = gr[128 * j]; gv[2 * j + 1] = gr[128 * j + 1]; }
        for (int m = gw; m < T; m += NGW) {
            const pg8::u32x4* hr = (const pg8::u32x4*)(HB0 + (size_t)m * D) + lane; f32x4* orow = (f32x4*)(out + (size_t)m * D) + 2 * lane;
            const float rs = pg8::row_rstd(ssx, m);
#pragma unroll
            for (int j = 0; j < 2; ++j) { const pg8::u32x4 w = hr[64 * j]; __builtin_nontemporal_store(pg8::bf_lo4(w) * rs * gv[2 * j], orow + 128 * j); __builtin_nontemporal_store(pg8::bf_hi4(w) * rs * gv[2 * j + 1], orow + 128 * j + 1); }
        }
    }
#undef IN
#undef tid
#undef lane
#undef SEAM
}

extern "C" void kernel_launch(void* const* d_in, const int* in_sizes, int n_in, void* d_out, int out_size, void* d_ws, size_t ws_size, hipStream_t stream) {
    static int grid = 0;
    if (grid == 0) {
        if (n_in != 18 || out_size != T * D || ws_size < WS_END) { fprintf(stderr, "kernel_launch: unexpected problem (n_in %d, out %d, ws %zu)\n", n_in, out_size, ws_size); grid = -1; return; }
        int dev = 0, cus = 0, per_cu = 0;
        hipGetDevice(&dev); hipDeviceGetAttribute(&cus, hipDeviceAttributeMultiprocessorCount, dev);
        hipFuncSetAttribute((const void*)mk_fwd, hipFuncAttributeMaxDynamicSharedMemorySize, LDS_BYTES);
        hipOccupancyMaxActiveBlocksPerMultiprocessor(&per_cu, (const void*)mk_fwd, NWAVES * 64, LDS_BYTES);
        (void)hipGetLastError();
        if (per_cu < 1) per_cu = 1;
        if (cus != 256) { fprintf(stderr, "kernel_launch: built for a 256-CU device (got %d)\n", cus); grid = -1; return; }
        grid = cus * 1;
        fprintf(stderr, "kernel_launch: grid %d (occupancy query %d per CU), ws %zu\n", grid, per_cu, ws_size);
    }
    if (grid < 0) return;
    if (hipMemsetAsync((char*)d_ws + WS_CTL, 0, CTL_BYTES, stream) != hipSuccess) { fprintf(stderr, "kernel_launch: memset failed\n"); return; }
    Args a{};
    for (int i = 0; i < 18; ++i) a.in[i] = (const float*)d_in[i];
    a.out = (float*)d_out; a.ws = (unsigned char*)d_ws;
    for (int c = 0; c < 8; ++c) a.inv_freq[c] = (float)pow(500000.0, -(double)(2 * c) / 16.0);
#if MK_N_LAUNCHES == 1
    a.ph_lo = 0; a.ph_hi = NPHASE;
    void* kargs[] = {&a};
    hipError_t e = hipLaunchCooperativeKernel((const void*)mk_fwd, dim3(grid), dim3(NWAVES * 64), kargs, LDS_BYTES, stream);
    if (e != hipSuccess) fprintf(stderr, "kernel_launch: cooperative launch failed: %s\n", hipGetErrorString(e));
#else
    for (int ph = 0; ph < NPHASE; ++ph) { a.ph_lo = ph; a.ph_hi = ph + 1;
        hipLaunchKernelGGL(mk_fwd, dim3(grid), dim3(NWAVES * 64), LDS_BYTES, stream, a);
#ifdef PROBE_PH
        if (ph == PROBE_PH) hipLaunchKernelGGL(mk_fwd, dim3(grid), dim3(NWAVES * 64), LDS_BYTES, stream, a);
#endif
    }
#endif
}
```
